# Optimizing an MI355X kernel written in HIP

```python
import jax
import jax.numpy as jnp
from jax import lax
import numpy as np

D_MODEL = 1024
BATCH = 8
SEQ = 4096
DEPTH = 2

GRID_W = 64
CTX_LEN = 256

CONV_DIM = 256
ATT_HEADS = 8
ATT_KV_HEADS = 2
ATT_HEAD_DIM = 64
ATT_WINDOW = 128
ATT_BLOCK = 128
ROPE_BASE = 10000.0
MLSTM_HEADS = 4
MLSTM_HEAD_DIM = 64
MLSTM_DIM = MLSTM_HEADS * MLSTM_HEAD_DIM
MLSTM_CHUNK = 64
N_BRANCHES = 3
N_GROUPS = 4
EXPERTS_PER_GROUP = 8
N_EXPERTS = N_GROUPS * EXPERTS_PER_GROUP
TOP_K = 2
D_EXPERT = D_MODEL // 2
EXPERT_BLOCK = 128
DEEPNORM_ALPHA = (2 * DEPTH) ** 0.25
DEEPNORM_BETA = (8 * DEPTH) ** -0.25
LN_EPS = 1e-6
NEG_INF = -1e30

SPLIT_SIZES = (
    CONV_DIM, CONV_DIM, CONV_DIM,
    ATT_HEADS * ATT_HEAD_DIM,
    ATT_KV_HEADS * ATT_HEAD_DIM,
    ATT_KV_HEADS * ATT_HEAD_DIM,
    MLSTM_DIM, MLSTM_DIM, MLSTM_DIM, MLSTM_DIM,
    4 * MLSTM_HEADS,
    N_BRANCHES * D_MODEL,
)
IN_COLS = sum(SPLIT_SIZES)

kernel_name = 'hybrid_flow_block'


def _layer_norm(x, gain=None, bias=None):
    xf = x.astype(jnp.float32)
    mu = jnp.mean(xf, axis=-1, keepdims=True)
    var = jnp.mean(jnp.square(xf - mu), axis=-1, keepdims=True)
    y = ((xf - mu) * lax.rsqrt(var + LN_EPS)).astype(x.dtype)
    if gain is not None:
        y = y * gain + bias
    return y


def _modulate(h, shift, scale):
    return h * (1 + scale) + shift


def _split_cols(z):
    offs = np.cumsum(SPLIT_SIZES)[:-1].tolist()
    return jnp.split(z, offs, axis=-1)


def _short_conv(u, w):
    up = jnp.pad(u, ((0, 0), (1, 1), (0, 0)))
    return up[:, :-2] * w[0] + up[:, 1:-1] * w[1] + up[:, 2:] * w[2]


def _rope_tables(n_tokens):
    rows = n_tokens // GRID_W
    pos_r = jnp.repeat(jnp.arange(rows, dtype=jnp.float32), GRID_W)
    pos_c = jnp.tile(jnp.arange(GRID_W, dtype=jnp.float32), rows)
    nf = ATT_HEAD_DIM // 4
    inv = ROPE_BASE ** (-jnp.arange(nf, dtype=jnp.float32) / nf)
    ang_r = pos_r[:, None] * inv
    ang_c = pos_c[:, None] * inv
    return (jnp.cos(ang_r), jnp.sin(ang_r), jnp.cos(ang_c), jnp.sin(ang_c))


def _rotate_half(x, cos, sin):
    x1, x2 = jnp.split(x, 2, axis=-1)
    cos = cos[None, :, None, :].astype(x.dtype)
    sin = sin[None, :, None, :].astype(x.dtype)
    return jnp.concatenate([x1 * cos - x2 * sin, x2 * cos + x1 * sin], axis=-1)


def _rope_2d(x, tabs):
    cr, sr, cc, sc = tabs
    xr, xc = jnp.split(x, 2, axis=-1)
    return jnp.concatenate([_rotate_half(xr, cr, sr), _rotate_half(xc, cc, sc)], axis=-1)


def _window_attention(q, k, v, kc, vc, sink):
    B, L, H, dh = q.shape
    G = H // ATT_KV_HEADS
    nb = L // ATT_BLOCK
    n_ctx = kc.shape[1]
    scale = dh ** -0.5
    qb = q.reshape(B, nb, ATT_BLOCK, ATT_KV_HEADS, G, dh)
    pad = ((0, 0), (ATT_BLOCK, ATT_BLOCK), (0, 0), (0, 0))
    kp = jnp.pad(k, pad).reshape(B, nb + 2, ATT_BLOCK, ATT_KV_HEADS, dh)
    vp = jnp.pad(v, pad).reshape(B, nb + 2, ATT_BLOCK, ATT_KV_HEADS, dh)
    kw = jnp.concatenate([kp[:, :-2], kp[:, 1:-1], kp[:, 2:]], axis=2)
    vw = jnp.concatenate([vp[:, :-2], vp[:, 1:-1], vp[:, 2:]], axis=2)
    sink_l = jnp.broadcast_to(
        sink.astype(jnp.float32).reshape(ATT_KV_HEADS, G)[None, :, :, None, None],
        (B, ATT_KV_HEADS, G, ATT_BLOCK, 1))
    offs_q = jnp.arange(ATT_BLOCK)
    offs_k = jnp.arange(3 * ATT_BLOCK) - ATT_BLOCK

    def block(args):
        qi, ki, vi, bi = args
        qpos = bi * ATT_BLOCK + offs_q
        kpos = bi * ATT_BLOCK + offs_k
        valid = ((jnp.abs(qpos[:, None] - kpos[None, :]) <= ATT_WINDOW)
                 & (kpos >= 0)[None, :] & (kpos < L)[None, :])
        s_w = jnp.einsum('bqkgd,bskd->bkgqs', qi, ki, preferred_element_type=jnp.float32) * scale
        s_w = jnp.where(valid, s_w, NEG_INF)
        s_c = jnp.einsum('bqkgd,bskd->bkgqs', qi, kc, preferred_element_type=jnp.float32) * scale
        p = jax.nn.softmax(jnp.concatenate([s_c, s_w, sink_l], axis=-1), axis=-1)
        o = (jnp.einsum('bkgqs,bskd->bqkgd', p[..., :n_ctx].astype(vc.dtype), vc)
             + jnp.einsum('bkgqs,bskd->bqkgd', p[..., n_ctx:-1].astype(vi.dtype), vi))
        return o

    xs = (jnp.moveaxis(qb, 1, 0), jnp.moveaxis(kw, 1, 0), jnp.moveaxis(vw, 1, 0), jnp.arange(nb))
    o = lax.map(block, xs)
    return jnp.moveaxis(o, 0, 1).reshape(B, L, H * dh)


def _context_attention(q, k, v, sink):
    B, C, H, dh = q.shape
    G = H // ATT_KV_HEADS
    qg = q.reshape(B, C, ATT_KV_HEADS, G, dh)
    s = jnp.einsum('bqkgd,bskd->bkgqs', qg, k, preferred_element_type=jnp.float32) * dh ** -0.5
    s_sink = jnp.broadcast_to(
        sink.astype(jnp.float32).reshape(ATT_KV_HEADS, G)[None, :, :, None, None],
        (B, ATT_KV_HEADS, G, C, 1))
    p = jax.nn.softmax(jnp.concatenate([s, s_sink], axis=-1), axis=-1)[..., :-1]
    o = jnp.einsum('bkgqs,bskd->bqkgd', p.astype(v.dtype), v)
    return o.reshape(B, C, H * dh)


def _mlstm_chunkwise(q, k, v, li, lf, skip_chunks):
    B, T, H, dh = q.shape
    nc = T // MLSTM_CHUNK
    f32 = jnp.float32

    def chunks(t):
        return jnp.moveaxis(t.astype(f32).reshape(B, nc, MLSTM_CHUNK, H, -1), 3, 1)

    def gchunks(t):
        return jnp.moveaxis(t.astype(f32).reshape(B, nc, MLSTM_CHUNK, H), 3, 1)

    q, k, v = chunks(q), chunks(k) * dh ** -0.5, chunks(v)
    li, lf = gchunks(li), gchunks(lf)
    bcum = jnp.cumsum(lf, axis=-1)
    g = bcum[..., -1]
    w_loc = g[..., None] - bcum + li
    m_loc = jnp.max(w_loc, axis=-1)
    e_loc = jnp.exp(w_loc - m_loc[..., None])
    c_loc = jnp.einsum('bhncd,bhnce->bhnde', k * e_loc[..., None], v)
    n_loc = jnp.einsum('bhncd,bhnc->bhnd', k, e_loc)

    def step(carry, inp):
        c_st, n_st, m_st = carry
        g_j, c_j, n_j, m_j = inp
        m_new = jnp.maximum(g_j + m_st, m_j)
        a = jnp.exp(g_j + m_st - m_new)
        b = jnp.exp(m_j - m_new)
        c_new = a[..., None, None] * c_st + b[..., None, None] * c_j
        n_new = a[..., None] * n_st + b[..., None] * n_j
        return (c_new, n_new, m_new), (c_st, n_st, m_st)

    init = (jnp.zeros((B, H, dh, dh), f32), jnp.zeros((B, H, dh), f32), jnp.zeros((B, H), f32))
    xs = (jnp.moveaxis(g, 2, 0), jnp.moveaxis(c_loc, 2, 0), jnp.moveaxis(n_loc, 2, 0), jnp.moveaxis(m_loc, 2, 0))
    _, (c_prev, n_prev, m_prev) = lax.scan(step, init, xs)
    c_prev = jnp.moveaxis(c_prev, 0, 2)
    n_prev = jnp.moveaxis(n_prev, 0, 2)
    m_prev = jnp.moveaxis(m_prev, 0, 2)

    s = skip_chunks
    q, k, v, li, bcum = q[:, :, s:], k[:, :, s:], v[:, :, s:], li[:, :, s:], bcum[:, :, s:]
    c_prev, n_prev, m_prev = c_prev[:, :, s:], n_prev[:, :, s:], m_prev[:, :, s:]

    a = bcum + m_prev[..., None]
    dmat = bcum[..., :, None] - bcum[..., None, :] + li[..., None, :]
    lower = jnp.tril(jnp.ones((MLSTM_CHUNK, MLSTM_CHUNK), dtype=bool))
    dmat = jnp.where(lower, dmat, -jnp.inf)
    m = jnp.maximum(a, jnp.max(dmat, axis=-1))
    w_intra = jnp.exp(dmat - m[..., None])
    e_inter = jnp.exp(a - m)
    s_qk = jnp.einsum('bhnsd,bhnrd->bhnsr', q, k) * w_intra
    num = (jnp.einsum('bhnsr,bhnre->bhnse', s_qk, v)
           + e_inter[..., None] * jnp.einsum('bhnsd,bhnde->bhnse', q, c_prev))
    den = jnp.sum(s_qk, axis=-1) + e_inter * jnp.einsum('bhnsd,bhnd->bhns', q, n_prev)
    h = num / jnp.maximum(jnp.abs(den), jnp.exp(-m))[..., None]
    return jnp.moveaxis(h, 1, 3).reshape(B, -1, H, dh)


def _head_norm(h, w):
    hf = h.astype(jnp.float32)
    mu = jnp.mean(hf, axis=-1, keepdims=True)
    var = jnp.mean(jnp.square(hf - mu), axis=-1, keepdims=True)
    y = (hf - mu) * lax.rsqrt(var + LN_EPS)
    return y.reshape(h.shape[0], h.shape[1], -1) * w.astype(jnp.float32)


def _token_mixer(hl, hc, w_in, conv_w, attn_sink, gate_b, norm_w, w_pa, w_pb, w_pc, w_o, rope, need_ctx):
    B, L, _ = hl.shape
    n_ctx = hc.shape[1]
    zl = _split_cols(hl @ w_in)
    zc = _split_cols(hc @ w_in)

    def conv_mixer(z):
        return z[0] * _short_conv(z[1] * z[2], conv_w)

    ql = _rope_2d(zl[3].reshape(B, L, ATT_HEADS, ATT_HEAD_DIM), rope)
    kl = _rope_2d(zl[4].reshape(B, L, ATT_KV_HEADS, ATT_HEAD_DIM), rope)
    vl = zl[5].reshape(B, L, ATT_KV_HEADS, ATT_HEAD_DIM)
    qc = zc[3].reshape(B, n_ctx, ATT_HEADS, ATT_HEAD_DIM)
    kc = zc[4].reshape(B, n_ctx, ATT_KV_HEADS, ATT_HEAD_DIM)
    vc = zc[5].reshape(B, n_ctx, ATT_KV_HEADS, ATT_HEAD_DIM)

    def heads(t):
        return t.reshape(t.shape[0], t.shape[1], MLSTM_HEADS, MLSTM_HEAD_DIM)

    def seq(tc, tl, rev):
        if rev:
            return jnp.concatenate([jnp.flip(tc, axis=1), jnp.flip(tl, axis=1)], axis=1)
        return jnp.concatenate([tc, tl], axis=1)

    gates_l = zl[10].astype(jnp.float32) + gate_b.astype(jnp.float32)
    gates_c = zc[10].astype(jnp.float32) + gate_b.astype(jnp.float32)
    skip = 0 if need_ctx else n_ctx // MLSTM_CHUNK
    outs = []
    for d, rev in enumerate((False, True)):
        i_sl = slice(2 * d * MLSTM_HEADS, (2 * d + 1) * MLSTM_HEADS)
        f_sl = slice((2 * d + 1) * MLSTM_HEADS, (2 * d + 2) * MLSTM_HEADS)
        q_d = seq(heads(zc[6]), heads(zl[6]), rev)
        k_d = seq(heads(zc[7]), heads(zl[7]), rev)
        v_d = seq(heads(zc[8]), heads(zl[8]), rev)
        li_d = seq(gates_c[..., i_sl], gates_l[..., i_sl], rev)
        lf_d = jax.nn.log_sigmoid(seq(gates_c[..., f_sl], gates_l[..., f_sl], rev))
        outs.append(_mlstm_chunkwise(q_d, k_d, v_d, li_d, lf_d, skip))
    h_fwd, h_bwd = outs
    hm_l = h_fwd[:, -L:] + jnp.flip(h_bwd[:, -L:], axis=1)
    ym_l = jax.nn.sigmoid(zl[9]) * _head_norm(hm_l, norm_w).astype(hl.dtype)

    def merge(ya, yb, yc, g):
        g_a, g_b, g_c = jnp.split(jax.nn.sigmoid(g), N_BRANCHES, axis=-1)
        return (g_a * (ya @ w_pa) + g_b * (yb @ w_pb) + g_c * (yc @ w_pc)) @ w_o

    yl = merge(conv_mixer(zl), _window_attention(ql, kl, vl, kc, vc, attn_sink), ym_l, zl[11])
    if not need_ctx:
        return yl, None
    hm_c = h_fwd[:, :n_ctx] + jnp.flip(h_bwd[:, :n_ctx], axis=1)
    ym_c = jax.nn.sigmoid(zc[9]) * _head_norm(hm_c, norm_w).astype(hc.dtype)
    yc = merge(conv_mixer(zc), _context_attention(qc, kc, vc, attn_sink), ym_c, zc[11])
    return yl, yc


def _hier_moe(h, w_rg, b_rg, w_re, b_re, w_ei, w_eo):
    N, D = h.shape
    A = N * TOP_K
    P = -(-(A + N_EXPERTS * EXPERT_BLOCK) // EXPERT_BLOCK) * EXPERT_BLOCK
    NB = P // EXPERT_BLOCK
    rows = jnp.arange(N)
    g_logit = (h @ w_rg + b_rg).astype(jnp.float32)
    g_prob = jax.nn.softmax(g_logit, axis=-1)
    g_sel = jnp.argmax(g_logit, axis=-1).astype(jnp.int32)
    e_logit = (h @ w_re + b_re).astype(jnp.float32).reshape(N, N_GROUPS, EXPERTS_PER_GROUP)[rows, g_sel]
    top_l, top_i = lax.top_k(e_logit, TOP_K)
    wts = (jax.nn.softmax(top_l, axis=-1) * g_prob[rows, g_sel][:, None]).reshape(A)
    eid = (g_sel[:, None] * EXPERTS_PER_GROUP + top_i).reshape(A)
    tok = jnp.repeat(rows, TOP_K)
    order = jnp.argsort(eid)
    eid_s, tok_s, w_s = eid[order], tok[order], wts[order]
    counts = jnp.bincount(eid, length=N_EXPERTS)
    padded = (counts + EXPERT_BLOCK - 1) // EXPERT_BLOCK * EXPERT_BLOCK
    pad_end = jnp.cumsum(padded)
    pad_start = pad_end - padded
    start = jnp.cumsum(counts) - counts
    pos = pad_start[eid_s] + jnp.arange(A) - start[eid_s]
    buf_tok = jnp.full((P,), N, dtype=jnp.int32).at[pos].set(tok_s)
    buf_w = jnp.zeros((P,), h.dtype).at[pos].set(w_s.astype(h.dtype))
    blk_e = jnp.minimum(jnp.searchsorted(pad_end, jnp.arange(NB) * EXPERT_BLOCK, side='right'), N_EXPERTS - 1)
    h_pad = jnp.concatenate([h, jnp.zeros((1, D), h.dtype)], axis=0)
    xb = h_pad[buf_tok].reshape(NB, EXPERT_BLOCK, D)

    def expert_block(args):
        xblk, e = args
        gt, up = jnp.split(xblk @ w_ei[e], 2, axis=-1)
        return (jax.nn.silu(gt) * up) @ w_eo[e]

    yb = lax.map(expert_block, (xb, blk_e)).reshape(P, D)
    out = jax.ops.segment_sum(yb * buf_w[:, None], buf_tok, num_segments=N + 1)
    return out[:N]


def setup_inputs(seed: int = 0) -> dict:
    key = jax.random.key(seed)
    ks = jax.random.split(key, 26)

    def nrm(k, shape):
        return jax.random.normal(k, shape, jnp.float32)

    D = D_MODEL
    gate_offset = jnp.concatenate([
        jnp.zeros((MLSTM_HEADS,), jnp.float32), jnp.linspace(3.0, 6.0, MLSTM_HEADS, dtype=jnp.float32),
        jnp.zeros((MLSTM_HEADS,), jnp.float32), jnp.linspace(3.0, 6.0, MLSTM_HEADS, dtype=jnp.float32)])
    return {
        'x': nrm(ks[0], (BATCH, SEQ, D)),
        'c': nrm(ks[1], (BATCH, D)),
        'ctx': nrm(ks[2], (BATCH, CTX_LEN, D)),
        'c_ctx': nrm(ks[3], (D,)),
        'w_ada': nrm(ks[4], (DEPTH, D, 6 * D)) * (0.5 * D ** -0.5),
        'b_ada': 0.01 * nrm(ks[5], (DEPTH, 6 * D)),
        'w_in': nrm(ks[6], (DEPTH, D, IN_COLS)) * D ** -0.5,
        'conv_w': nrm(ks[7], (DEPTH, 3, CONV_DIM)) * 3 ** -0.5,
        'attn_sink': 0.5 * nrm(ks[8], (DEPTH, ATT_HEADS)),
        'mlstm_gate_b': gate_offset[None, :] + 0.1 * nrm(ks[9], (DEPTH, 4 * MLSTM_HEADS)),
        'mlstm_norm_w': 1.0 + 0.02 * nrm(ks[10], (DEPTH, MLSTM_DIM)),
        'w_proj_a': nrm(ks[11], (DEPTH, CONV_DIM, D)) * (CONV_DIM ** -0.5 * DEEPNORM_BETA),
        'w_proj_b': nrm(ks[12], (DEPTH, ATT_HEADS * ATT_HEAD_DIM, D)) * ((ATT_HEADS * ATT_HEAD_DIM) ** -0.5 * DEEPNORM_BETA),
        'w_proj_c': nrm(ks[13], (DEPTH, MLSTM_DIM, D)) * (MLSTM_DIM ** -0.5 * DEEPNORM_BETA),
        'w_out': nrm(ks[14], (DEPTH, D, D)) * (D ** -0.5 * DEEPNORM_BETA),
        'ln1_g': 1.0 + 0.02 * nrm(ks[15], (DEPTH, D)),
        'ln1_b': 0.02 * nrm(ks[16], (DEPTH, D)),
        'w_route_group': nrm(ks[17], (DEPTH, D, N_GROUPS)) * D ** -0.5,
        'b_route_group': 0.01 * nrm(ks[18], (DEPTH, N_GROUPS)),
        'w_route_expert': nrm(ks[19], (DEPTH, D, N_EXPERTS)) * D ** -0.5,
        'b_route_expert': 0.01 * nrm(ks[20], (DEPTH, N_EXPERTS)),
        'w_expert_in': nrm(ks[21], (DEPTH, N_EXPERTS, D, 2 * D_EXPERT)) * D ** -0.5,
        'w_expert_out': nrm(ks[22], (DEPTH, N_EXPERTS, D_EXPERT, D)) * (D_EXPERT ** -0.5 * DEEPNORM_BETA),
        'ln2_g': 1.0 + 0.02 * nrm(ks[23], (DEPTH, D)),
        'ln2_b': 0.02 * nrm(ks[24], (DEPTH, D)),
    }


def reference(x, c, ctx, c_ctx, w_ada, b_ada, w_in, conv_w, attn_sink, mlstm_gate_b, mlstm_norm_w,
              w_proj_a, w_proj_b, w_proj_c, w_out, ln1_g, ln1_b, w_route_group, b_route_group,
              w_route_expert, b_route_expert, w_expert_in, w_expert_out, ln2_g, ln2_b):
    B, L, D = x.shape
    n_ctx = ctx.shape[1]
    rope = _rope_tables(L)
    s_lat = jax.nn.silu(c)
    s_ctx = jax.nn.silu(c_ctx)
    for i in range(DEPTH):
        need_ctx = i < DEPTH - 1
        mod_l = jnp.split((s_lat @ w_ada[i] + b_ada[i])[:, None, :], 6, axis=-1)
        mod_c = jnp.split(s_ctx @ w_ada[i] + b_ada[i], 6, axis=-1)
        hl = _modulate(_layer_norm(x), mod_l[0], mod_l[1])
        hc = _modulate(_layer_norm(ctx), mod_c[0], mod_c[1])
        yl, yc = _token_mixer(hl, hc, w_in[i], conv_w[i], attn_sink[i], mlstm_gate_b[i], mlstm_norm_w[i],
                              w_proj_a[i], w_proj_b[i], w_proj_c[i], w_out[i], rope, need_ctx)
        x = _layer_norm(DEEPNORM_ALPHA * x + mod_l[2] * yl, ln1_g[i], ln1_b[i])
        hl2 = _modulate(_layer_norm(x), mod_l[3], mod_l[4]).reshape(B * L, D)
        if need_ctx:
            ctx = _layer_norm(DEEPNORM_ALPHA * ctx + mod_c[2] * yc, ln1_g[i], ln1_b[i])
            hc2 = _modulate(_layer_norm(ctx), mod_c[3], mod_c[4]).reshape(B * n_ctx, D)
            f = _hier_moe(jnp.concatenate([hl2, hc2], axis=0), w_route_group[i], b_route_group[i],
                          w_route_expert[i], b_route_expert[i], w_expert_in[i], w_expert_out[i])
            fl = f[:B * L].reshape(B, L, D)
            fc = f[B * L:].reshape(B, n_ctx, D)
            ctx = _layer_norm(DEEPNORM_ALPHA * ctx + mod_c[5] * fc, ln2_g[i], ln2_b[i])
        else:
            fl = _hier_moe(hl2, w_route_group[i], b_route_group[i], w_route_expert[i],
                           b_route_expert[i], w_expert_in[i], w_expert_out[i]).reshape(B, L, D)
        x = _layer_norm(DEEPNORM_ALPHA * x + mod_l[5] * fl, ln2_g[i], ln2_b[i])
    return x
```

```cpp
#include <hip/hip_runtime.h>
#include <cstdio>
#include <cstdint>
#ifndef MK_ONE_LAUNCH
#define MK_ONE_LAUNCH 1
#endif

namespace pg8 {
#define PG8_LAS __attribute__((address_space(3)))
typedef unsigned short bf16_t;
typedef short bf16x8 __attribute__((ext_vector_type(8)));
typedef float f32x4 __attribute__((ext_vector_type(4)));
typedef unsigned u32x4 __attribute__((ext_vector_type(4)));
constexpr int BM = 256, BK = 64, HALF = 128, HTB = HALF * BK * 2  , STAGE_BYTES = 8 * HTB, NXCD = 8, WGM = 8;

__host__ __device__ __forceinline__ int lds_byte(int r, int c) { const int st = (r >> 4) * 2 + (c >> 5), rr = r & 15, cc = c & 31, ob = rr * 64 + cc * 2; return st * 1024 + (ob ^ (((ob >> 9) & 1) << 5)); }
__host__ __device__ __forceinline__ void stage_rc(int b, int& R, int& C) { const int st = b / 1024, sb = b % 1024, swz = sb ^ (((sb >> 9) & 1) << 5); R = (st >> 1) * 16 + swz / 64; C = (st & 1) * 32 + (swz % 64) / 2; }
__host__ __device__ __forceinline__ int perm32(int rho) { const int n = rho >> 4, i = rho & 15; return 8 * (i >> 2) + 4 * n + (i & 3); }

struct Unit { int pm, pn, bn, kh; };
struct Gemm { const bf16_t* A; const bf16_t* Bt; int M, N, K, KT; };

struct StaticOrder {
    int nM, nN, nwg, G, c;
    __host__ __device__ void init(int M, int N, int G_, int c_) { nM = M / BM; nN = N / BM; nwg = nM * nN; G = G_; c = c_; }
    __host__ __device__ bool next(int i, Unit& u) const {
        const long L = (long)i * G + c; if (L >= nwg) return false;
        int wgid = (int)L; { const int q = nwg / NXCD, r = nwg % NXCD, xcd = wgid % NXCD, off = wgid / NXCD; wgid = (xcd < r ? xcd * (q + 1) : r * (q + 1) + (xcd - r) * q) + off; }
        const int nig = WGM * nN, gid = wgid / nig, fm = gid * WGM, gsz = (nM - fm) < WGM ? (nM - fm) : WGM;
        u.pm = fm + ((wgid % nig) % gsz); u.pn = (wgid % nig) / gsz; u.bn = u.pn; return true;
    }
    static constexpr bool GATHER = false;
    __device__ __forceinline__ int a_tile(const Unit& u) const { return u.pm; }
    __device__ __forceinline__ size_t k_off(const Unit&) const { return 0; }
    __device__ __forceinline__ bool carry(const Unit&) const { return false; }
    __device__ __forceinline__ void a_ready(const Unit&) const {}
    __device__ __forceinline__ void done(const Unit&) const {}
};

__device__ __forceinline__ unsigned cvt_pk_bf16(float lo, float hi) { unsigned r; asm volatile("v_cvt_pk_bf16_f32 %0, %1, %2" : "=v"(r) : "v"(lo), "v"(hi)); return r; }
typedef float f32x2 __attribute__((ext_vector_type(2)));
__device__ __forceinline__ f32x2 gelu_pk(f32x2 v) {
    const f32x2 av = __builtin_elementwise_abs(v), d = av * 0.2316418882f + 1.0f;
    f32x2 t; t.x = __builtin_amdgcn_rcpf(d.x); t.y = __builtin_amdgcn_rcpf(d.y);
    f32x2 q = t * 0.5307027145f + (-0.7265760135f); q = q * t + 0.7107068705f; q = q * t + (-0.142248368f); q = q * t + 0.127414796f; q = q * t;
    const f32x2 s = (v * v) * (-0.72134752044f);
    f32x2 e; e.x = __builtin_amdgcn_exp2f(s.x); e.y = __builtin_amdgcn_exp2f(s.y);
    const f32x2 m = v * (q * e), r = v - m;
    f32x2 o; o.x = v.x < 0.f ? m.x : r.x; o.y = v.y < 0.f ? m.y : r.y; return o;
}

template <int ACT  > struct EpiBf16 {
    static constexpr bool PERM = true, AFTER_DRAIN = false; static_assert(ACT == 0 || ACT == 1, "EpiBf16: ACT is 0 (none) or 1 (gelu_pk)");
    bf16_t* O; int ldc; const float* bias; int split_cols; size_t split_stride; float scale0;
    __device__ __forceinline__ void operator()(const f32x4 (&acc)[2][2][4][2], const Unit& u, int wr, int wc, int fr, int fq) const {
        const int row0 = u.pm * BM + wr * 64 + fr; int colt = u.pn * BM; bf16_t* base = O;
        float sc = 1.f; if (split_cols) { const int t = colt / split_cols; base += (size_t)t * split_stride; colt -= t * split_cols; if (t == 0) sc = scale0; }
        const int col0 = colt + wc * 32 + 8 * fq, bcol0 = u.pn * BM + wc * 32 + 8 * fq;
        f32x4 bv[2][2];
#pragma unroll
        for (int bj = 0; bj < 2; ++bj)
#pragma unroll
            for (int n = 0; n < 2; ++n) bv[bj][n] = bias ? *(const f32x4*)(bias + bcol0 + bj * HALF + 4 * n) : (f32x4){0.f, 0.f, 0.f, 0.f};
#pragma unroll
        for (int ai = 0; ai < 2; ++ai)
#pragma unroll
            for (int m = 0; m < 4; ++m) { bf16_t* rowp = base + (size_t)(row0 + ai * HALF + m * 16) * ldc + col0;
#pragma unroll
                for (int bj = 0; bj < 2; ++bj) { f32x4 v0 = acc[ai][bj][m][0] + bv[bj][0], v1 = acc[ai][bj][m][1] + bv[bj][1];
                    if (ACT == 1) { f32x2 a = gelu_pk((f32x2){v0[0], v0[1]}), b = gelu_pk((f32x2){v0[2], v0[3]}), c = gelu_pk((f32x2){v1[0], v1[1]}), d = gelu_pk((f32x2){v1[2], v1[3]});
                        v0 = (f32x4){a.x, a.y, b.x, b.y}; v1 = (f32x4){c.x, c.y, d.x, d.y}; }
                    v0 = v0 * sc; v1 = v1 * sc; u32x4 w; w.x = cvt_pk_bf16(v0[0], v0[1]); w.y = cvt_pk_bf16(v0[2], v0[3]); w.z = cvt_pk_bf16(v1[0], v1[1]); w.w = cvt_pk_bf16(v1[2], v1[3]);
                    *(u32x4*)(rowp + bj * HALF) = w; } }
    }
};

__device__ __forceinline__ float fsigmoid(float x) { return __builtin_amdgcn_rcpf(1.0f + __expf(-x)); }
__device__ __forceinline__ float bflo(unsigned w) { return __uint_as_float(w << 16); }
__device__ __forceinline__ float bfhi(unsigned w) { return __uint_as_float(w & 0xffff0000u); }

struct EpiZ {
    static constexpr bool PERM = true, AFTER_DRAIN = false;
    bf16_t* Z; int ldz; unsigned char* G8; int ldg; int nz;
    __device__ __forceinline__ void operator()(const f32x4 (&acc)[2][2][4][2], const Unit& u, int wr, int wc, int fr, int fq) const {
        const int row0 = u.pm * BM + wr * 64 + fr;
        if (u.pn < nz) {
            const int col0 = u.pn * BM + wc * 32 + 8 * fq;
#pragma unroll
            for (int ai = 0; ai < 2; ++ai)
#pragma unroll
                for (int m = 0; m < 4; ++m) { bf16_t* rowp = Z + (size_t)(row0 + ai * HALF + m * 16) * ldz + col0;
#pragma unroll
                    for (int bj = 0; bj < 2; ++bj) { const f32x4 v0 = acc[ai][bj][m][0], v1 = acc[ai][bj][m][1];
                        u32x4 w; w.x = cvt_pk_bf16(v0[0], v0[1]); w.y = cvt_pk_bf16(v0[2], v0[3]); w.z = cvt_pk_bf16(v1[0], v1[1]); w.w = cvt_pk_bf16(v1[2], v1[3]);
                        *(u32x4*)(rowp + bj * HALF) = w; } }
        } else {
            const int col0 = (u.pn - nz) * BM + wc * 32 + 8 * fq;
#pragma unroll
            for (int ai = 0; ai < 2; ++ai)
#pragma unroll
                for (int m = 0; m < 4; ++m) { unsigned char* rowp = G8 + (size_t)(row0 + ai * HALF + m * 16) * ldg + col0;
#pragma unroll
                    for (int bj = 0; bj < 2; ++bj) { const f32x4 v0 = acc[ai][bj][m][0], v1 = acc[ai][bj][m][1]; unsigned lo = 0u, hi = 0u;
                        lo = __builtin_amdgcn_cvt_pk_u8_f32(255.0f * fsigmoid(v0[0]), 0, lo); lo = __builtin_amdgcn_cvt_pk_u8_f32(255.0f * fsigmoid(v0[1]), 1, lo);
                        lo = __builtin_amdgcn_cvt_pk_u8_f32(255.0f * fsigmoid(v0[2]), 2, lo); lo = __builtin_amdgcn_cvt_pk_u8_f32(255.0f * fsigmoid(v0[3]), 3, lo);
                        hi = __builtin_amdgcn_cvt_pk_u8_f32(255.0f * fsigmoid(v1[0]), 0, hi); hi = __builtin_amdgcn_cvt_pk_u8_f32(255.0f * fsigmoid(v1[1]), 1, hi);
                        hi = __builtin_amdgcn_cvt_pk_u8_f32(255.0f * fsigmoid(v1[2]), 2, hi); hi = __builtin_amdgcn_cvt_pk_u8_f32(255.0f * fsigmoid(v1[3]), 3, hi);
                        typedef unsigned u32x2 __attribute__((ext_vector_type(2))); *(u32x2*)(rowp + bj * HALF) = (u32x2){lo, hi}; } }
        }
    }
};
struct EpiNull {
    static constexpr bool PERM = true, AFTER_DRAIN = false;
    __device__ __forceinline__ void operator()(const f32x4 (&acc)[2][2][4][2], const Unit&, int, int, int, int) const {
#pragma unroll
        for (int a = 0; a < 2; ++a)
#pragma unroll
            for (int b = 0; b < 2; ++b)
#pragma unroll
                for (int m = 0; m < 4; ++m)
#pragma unroll
                    for (int n = 0; n < 2; ++n) asm volatile("" :: "v"(acc[a][b][m][n]));
    }
};
#ifndef PROBE_EPIFLAGS
#define PROBE_EPIFLAGS 0
#endif
template <class E> struct epi_probe_flags { static constexpr int v = 0; };
template <> struct epi_probe_flags<EpiNull> { static constexpr int v = PROBE_EPIFLAGS; };
struct EpiMerge {
    static constexpr bool PERM = true, AFTER_DRAIN = false;
    const unsigned char* gate; int ldg; bf16_t* O; int ldo; int nrt; unsigned char* O8;
    __device__ __forceinline__ void operator()(const f32x4 (&acc)[2][2][4][2], const Unit& u, int wr, int wc, int fr, int fq) const {
        typedef unsigned u32x2 __attribute__((ext_vector_type(2)));
        const int br = u.pm / nrt, pm = u.pm - br * nrt, gsel = (br + 1) >> 1;
        const int row0 = pm * BM + wr * 64 + fr, col0 = u.pn * BM + wc * 32 + 8 * fq;
        const unsigned char* gp = gate + (size_t)row0 * ldg + gsel * 1024 + col0; bf16_t* op = O + (size_t)row0 * ldo + col0;
        u32x2 g[2][4][2];
#pragma unroll
        for (int ai = 0; ai < 2; ++ai)
#pragma unroll
            for (int m = 0; m < 4; ++m)
#pragma unroll
                for (int bj = 0; bj < 2; ++bj) g[ai][m][bj] = *(const u32x2*)(gp + (size_t)(ai * HALF + m * 16) * ldg + bj * HALF);
        constexpr float S = 1.0f / 255.0f;
#pragma unroll
        for (int ai = 0; ai < 2; ++ai) {
            asm volatile("" : "+v"(op) :: "memory");
            u32x4 p[4][2];
#pragma unroll
            for (int m = 0; m < 4; ++m)
#pragma unroll
                for (int bj = 0; bj < 2; ++bj) { if (br != 0) p[m][bj] = *(const u32x4*)(op + (size_t)(m * 16) * ldo + bj * HALF); else p[m][bj] = (u32x4){0u, 0u, 0u, 0u}; }
#pragma unroll
            for (int m = 0; m < 4; ++m)
#pragma unroll
                for (int bj = 0; bj < 2; ++bj) { const u32x2 gg = g[ai][m][bj]; const u32x4 pp = p[m][bj];
                    f32x4 v0 = acc[ai][bj][m][0], v1 = acc[ai][bj][m][1];
                    v0[0] = v0[0] * ((float)(gg.x & 0xffu) * S) + bflo(pp.x); v0[1] = v0[1] * ((float)((gg.x >> 8) & 0xffu) * S) + bfhi(pp.x);
                    v0[2] = v0[2] * ((float)((gg.x >> 16) & 0xffu) * S) + bflo(pp.y); v0[3] = v0[3] * ((float)(gg.x >> 24) * S) + bfhi(pp.y);
                    v1[0] = v1[0] * ((float)(gg.y & 0xffu) * S) + bflo(pp.z); v1[1] = v1[1] * ((float)((gg.y >> 8) & 0xffu) * S) + bfhi(pp.z);
                    v1[2] = v1[2] * ((float)((gg.y >> 16) & 0xffu) * S) + bflo(pp.w); v1[3] = v1[3] * ((float)(gg.y >> 24) * S) + bfhi(pp.w);
                    if (br == 3) { int lo8 = 0, hi8 = 0; lo8 = __builtin_amdgcn_cvt_pk_fp8_f32(v0[0], v0[1], lo8, false); lo8 = __builtin_amdgcn_cvt_pk_fp8_f32(v0[2], v0[3], lo8, true);
                        hi8 = __builtin_amdgcn_cvt_pk_fp8_f32(v1[0], v1[1], hi8, false); hi8 = __builtin_amdgcn_cvt_pk_fp8_f32(v1[2], v1[3], hi8, true);
                        *(u32x2*)(O8 + ((size_t)((op - O) + (size_t)(m * 16) * ldo + bj * HALF))) = (u32x2){(unsigned)lo8, (unsigned)hi8}; }
                    else { u32x4 w; w.x = cvt_pk_bf16(v0[0], v0[1]); w.y = cvt_pk_bf16(v0[2], v0[3]); w.z = cvt_pk_bf16(v1[0], v1[1]); w.w = cvt_pk_bf16(v1[2], v1[3]);
                        *(u32x4*)(op + (size_t)(m * 16) * ldo + bj * HALF) = w; } }
            op += (size_t)HALF * ldo;
        }
    }
};
struct MergeOrder {
    int ntiles, nrt, G, c;
    __device__ __forceinline__ bool next(int i, Unit& u) const {
        const int t = (i >> 2) * G + c, br = i & 3; if (t >= ntiles) return false;
        u.pm = br * nrt + (t >> 2); u.pn = t & 3; u.bn = br * 4 + (t & 3); return true; }
    static constexpr bool GATHER = false;
    __device__ __forceinline__ int a_tile(const Unit& u) const { return u.pm; }
    __device__ __forceinline__ size_t k_off(const Unit&) const { return 0; }
    __device__ __forceinline__ bool carry(const Unit& u) const { return u.pm / nrt == 1; }
    __device__ __forceinline__ void a_ready(const Unit&) const {}
    __device__ __forceinline__ void done(const Unit&) const {}
};
struct EpiSwiGLU {
    static constexpr bool PERM = true, AFTER_DRAIN = false;
    bf16_t* O; int ldo;
    __device__ __forceinline__ void operator()(const f32x4 (&acc)[2][2][4][2], const Unit& u, int wr, int wc, int fr, int fq) const {
        const int row0 = u.pm * BM + wr * 64 + fr, col0 = u.pn * HALF + wc * 32 + 8 * fq;
#pragma unroll
        for (int ai = 0; ai < 2; ++ai)
#pragma unroll
            for (int m = 0; m < 4; ++m) {
                f32x4 g0 = acc[ai][0][m][0], g1 = acc[ai][0][m][1]; const f32x4 u0 = acc[ai][1][m][0], u1 = acc[ai][1][m][1];
#pragma unroll
                for (int j = 0; j < 4; ++j) { g0[j] = g0[j] * fsigmoid(g0[j]) * u0[j]; g1[j] = g1[j] * fsigmoid(g1[j]) * u1[j]; }
                u32x4 w; w.x = cvt_pk_bf16(g0[0], g0[1]); w.y = cvt_pk_bf16(g0[2], g0[3]); w.z = cvt_pk_bf16(g1[0], g1[1]); w.w = cvt_pk_bf16(g1[2], g1[3]);
                *(u32x4*)(O + (size_t)(row0 + ai * HALF + m * 16) * ldo + col0) = w; }
    }
};
struct EpiSwiGLU8 {
    static constexpr bool PERM = true, AFTER_DRAIN = false;
    unsigned char* O; int ldo; float s;
    __device__ __forceinline__ void operator()(const f32x4 (&acc)[2][2][4][2], const Unit& u, int wr, int wc, int fr, int fq) const {
        typedef unsigned u32x2 __attribute__((ext_vector_type(2)));
        const int row0 = u.pm * BM + wr * 64 + fr, col0 = u.pn * HALF + wc * 32 + 8 * fq;
#pragma unroll
        for (int ai = 0; ai < 2; ++ai)
#pragma unroll
            for (int m = 0; m < 4; ++m) {
                f32x4 g0 = acc[ai][0][m][0] * s, g1 = acc[ai][0][m][1] * s; const f32x4 u0 = acc[ai][1][m][0] * s, u1 = acc[ai][1][m][1] * s;
#pragma unroll
                for (int j = 0; j < 4; ++j) { g0[j] = g0[j] * fsigmoid(g0[j]) * u0[j]; g1[j] = g1[j] * fsigmoid(g1[j]) * u1[j]; }
                int lo = 0, hi = 0;
                lo = __builtin_amdgcn_cvt_pk_fp8_f32(g0[0], g0[1], lo, false); lo = __builtin_amdgcn_cvt_pk_fp8_f32(g0[2], g0[3], lo, true);
                hi = __builtin_amdgcn_cvt_pk_fp8_f32(g1[0], g1[1], hi, false); hi = __builtin_amdgcn_cvt_pk_fp8_f32(g1[2], g1[3], hi, true);
                *(u32x2*)(O + (size_t)(row0 + ai * HALF + m * 16) * ldo + col0) = (u32x2){(unsigned)lo, (unsigned)hi};
                __builtin_amdgcn_sched_barrier(0); }
    }
};
struct EpiBf16S {
    static constexpr bool PERM = true, AFTER_DRAIN = false;
    bf16_t* O; int ldc; float s;
    __device__ __forceinline__ void operator()(const f32x4 (&acc)[2][2][4][2], const Unit& u, int wr, int wc, int fr, int fq) const {
        const int row0 = u.pm * BM + wr * 64 + fr, col0 = u.pn * BM + wc * 32 + 8 * fq;
#pragma unroll
        for (int ai = 0; ai < 2; ++ai)
#pragma unroll
            for (int m = 0; m < 4; ++m) { bf16_t* rowp = O + (size_t)(row0 + ai * HALF + m * 16) * ldc + col0;
#pragma unroll
                for (int bj = 0; bj < 2; ++bj) { const f32x4 v0 = acc[ai][bj][m][0] * s, v1 = acc[ai][bj][m][1] * s;
                    u32x4 w; w.x = cvt_pk_bf16(v0[0], v0[1]); w.y = cvt_pk_bf16(v0[2], v0[3]); w.z = cvt_pk_bf16(v1[0], v1[1]); w.w = cvt_pk_bf16(v1[2], v1[3]);
                    *(u32x4*)(rowp + bj * HALF) = w; } }
    }
};
struct EpiG8 {
    static constexpr bool PERM = true, AFTER_DRAIN = false;
    unsigned char* G8; int ldg; float s;
    __device__ __forceinline__ void operator()(const f32x4 (&acc)[2][2][4][2], const Unit& u, int wr, int wc, int fr, int fq) const {
        const int row0 = u.pm * BM + wr * 64 + fr, col0 = u.pn * BM + wc * 32 + 8 * fq;
#pragma unroll
        for (int ai = 0; ai < 2; ++ai)
#pragma unroll
            for (int m = 0; m < 4; ++m) { unsigned char* rowp = G8 + (size_t)(row0 + ai * HALF + m * 16) * ldg + col0;
#pragma unroll
                for (int bj = 0; bj < 2; ++bj) { const f32x4 v0 = acc[ai][bj][m][0] * s, v1 = acc[ai][bj][m][1] * s; unsigned lo = 0u, hi = 0u;
                    lo = __builtin_amdgcn_cvt_pk_u8_f32(255.0f * fsigmoid(v0[0]), 0, lo); lo = __builtin_amdgcn_cvt_pk_u8_f32(255.0f * fsigmoid(v0[1]), 1, lo);
                    lo = __builtin_amdgcn_cvt_pk_u8_f32(255.0f * fsigmoid(v0[2]), 2, lo); lo = __builtin_amdgcn_cvt_pk_u8_f32(255.0f * fsigmoid(v0[3]), 3, lo);
                    hi = __builtin_amdgcn_cvt_pk_u8_f32(255.0f * fsigmoid(v1[0]), 0, hi); hi = __builtin_amdgcn_cvt_pk_u8_f32(255.0f * fsigmoid(v1[1]), 1, hi);
                    hi = __builtin_amdgcn_cvt_pk_u8_f32(255.0f * fsigmoid(v1[2]), 2, hi); hi = __builtin_amdgcn_cvt_pk_u8_f32(255.0f * fsigmoid(v1[3]), 3, hi);
                    typedef unsigned u32x2 __attribute__((ext_vector_type(2))); *(u32x2*)(rowp + bj * HALF) = (u32x2){lo, hi}; } }
    }
};
struct EpiF8S {
    static constexpr bool PERM = true, AFTER_DRAIN = false;
    unsigned char* O; int ldc; float s;
    __device__ __forceinline__ void operator()(const f32x4 (&acc)[2][2][4][2], const Unit& u, int wr, int wc, int fr, int fq) const {
        typedef unsigned u32x2 __attribute__((ext_vector_type(2)));
        const int row0 = u.pm * BM + wr * 64 + fr, col0 = u.pn * BM + wc * 32 + 8 * fq;
#pragma unroll
        for (int ai = 0; ai < 2; ++ai)
#pragma unroll
            for (int m = 0; m < 4; ++m) { unsigned char* rowp = O + (size_t)(row0 + ai * HALF + m * 16) * ldc + col0;
#pragma unroll
                for (int bj = 0; bj < 2; ++bj) { const f32x4 v0 = acc[ai][bj][m][0] * s, v1 = acc[ai][bj][m][1] * s; int lo = 0, hi = 0;
                    lo = __builtin_amdgcn_cvt_pk_fp8_f32(v0[0], v0[1], lo, false); lo = __builtin_amdgcn_cvt_pk_fp8_f32(v0[2], v0[3], lo, true);
                    hi = __builtin_amdgcn_cvt_pk_fp8_f32(v1[0], v1[1], hi, false); hi = __builtin_amdgcn_cvt_pk_fp8_f32(v1[2], v1[3], hi, true);
                    *(u32x2*)(rowp + bj * HALF) = (u32x2){(unsigned)lo, (unsigned)hi}; } }
    }
};
struct InprojOrder {
    StaticOrder base; int nextra, pm0;
    __device__ __forceinline__ bool next(int i, Unit& u) const {
        const long L = (long)i * base.G + base.c; if (L < base.nwg) return base.next(i, u);
        const int e = (int)(L - base.nwg); if (e >= nextra) return false;
        const int q = e / 3, x = e - 3 * q; u.pm = pm0 + q; u.pn = (x == 0) ? 5 : (x == 1 ? 7 : 8); u.bn = u.pn; return true; }
    static constexpr bool GATHER = false;
    __device__ __forceinline__ int a_tile(const Unit& u) const { return u.pm; }
    __device__ __forceinline__ size_t k_off(const Unit&) const { return 0; }
    __device__ __forceinline__ bool carry(const Unit&) const { return false; }
    __device__ __forceinline__ void a_ready(const Unit&) const {}
    __device__ __forceinline__ void done(const Unit&) const {}
};
struct MoeOrder {
    const PG8_LAS int* tile_e; int ntiles, G, c;
    __device__ __forceinline__ static void unit_of(int i, int G, int c, int& t, int& pn) {
        if (G == 256) { t = i * 64 + (c & 7) * 8 + (c >> 5); pn = (c >> 3) & 3; } else { const long L = (long)i * G + c; t = (int)(L >> 2); pn = (int)(L & 3); } }
    __device__ __forceinline__ bool next(int i, Unit& u) const {
        int t, pn; unit_of(i, G, c, t, pn); if (t >= ntiles) return false;
        u.pm = t; u.pn = pn; u.bn = __builtin_amdgcn_readfirstlane(tile_e[t]) * 4 + pn; return true; }
    static constexpr bool GATHER = false;
    __device__ __forceinline__ int a_tile(const Unit& u) const { return u.pm; }
    __device__ __forceinline__ size_t k_off(const Unit&) const { return 0; }
    __device__ __forceinline__ bool carry(const Unit&) const { return false; }
    __device__ __forceinline__ void a_ready(const Unit&) const {}
    __device__ __forceinline__ void done(const Unit&) const {}
};
struct MoeGatherOrder : MoeOrder {
    const PG8_LAS int* tok;
    static constexpr bool GATHER = true;
    __device__ __forceinline__ int a_tile(const Unit&) const { return 0; }
    __device__ __forceinline__ void offsets(int i, int tid, int K, unsigned (&out)[2][2]) const {
#pragma unroll
        for (int p = 0; p < 2; ++p) { int R, C; stage_rc(tid * 16 + p * 8192, R, C);
#pragma unroll
            for (int h = 0; h < 2; ++h) out[h][p] = (unsigned)(tok[i * 256 + h * 128 + R] * K + C) * 2u; } }
};

typedef int i32x4_ __attribute__((ext_vector_type(4))); typedef int i32x8_ __attribute__((ext_vector_type(8)));
template <class Epi, class Sched, bool ALIGN_EPI = false, bool SP2 = false, bool FP8 = false>
__device__ __forceinline__ void gemm_phase(PG8_LAS unsigned char* lds, const Gemm g, const Sched& S, const Epi& E, const int tid_in) {
    const int tid = tid_in, wid = __builtin_amdgcn_readfirstlane(tid >> 6), lane = tid & 63, wr = wid >> 2, wc = wid & 3, fr = lane & 15, fq = lane >> 4;
    const int K = g.K, nt = g.KT ? g.KT : K / BK;
    unsigned voffA[2], voffB[2];
#pragma unroll
    for (int i = 0; i < 2; ++i) { int R, C; stage_rc(tid * 16 + i * 8192, R, C); const int Rb = Epi::PERM ? ((R & ~31) + perm32(R & 31)) : R;
        voffA[i] = (unsigned)(R * K + C) * 2u; voffB[i] = (unsigned)(Rb * K + C) * 2u; }
    unsigned voC[2][2] = {{0u, 0u}, {0u, 0u}}, voN[2][2] = {{0u, 0u}, {0u, 0u}};
    const size_t kstep = (size_t)(BK * 2);
    const size_t hstep = (size_t)HALF * K * 2;
    const size_t tstep = 2 * hstep;
    const unsigned ldsw = (unsigned)wid * 1024u;
    const int aoff = lds_byte(wr * 64 + fr, fq * 8), boff = lds_byte(wc * 32 + fr, fq * 8);
#define PG8_SA(b, h) (((b) * 2 + (h)) * HTB)
#define PG8_SB(b, h) ((4 + (b) * 2 + (h)) * HTB)
#define PG8_STAGE(bufoff, gbase, voff) do { _Pragma("unroll") for (int _i = 0; _i < 2; ++_i) \
        __builtin_amdgcn_global_load_lds((const unsigned*)((const char*)(gbase) + (voff)[_i]), (PG8_LAS unsigned*)(lds + (bufoff) + ldsw + _i * 8192), 16, 0, 0); } while (0)
#define PG8_STAGE_A(bufoff, gptr, h, nx) do { if constexpr (Sched::GATHER) { const unsigned vsel_[2] = {(nx) ? voN[h][0] : voC[h][0], (nx) ? voN[h][1] : voC[h][1]}; PG8_STAGE(bufoff, gptr, vsel_); } \
        else { PG8_STAGE(bufoff, (gptr) + (h) * hstep, voffA); } } while (0)
#define PG8_LDA(dst, b, h) do { if constexpr (FP8) { _Pragma("unroll") for (int m = 0; m < 4; ++m) dst##8[m] = __builtin_shufflevector(*(const PG8_LAS i32x4_*)(lds + PG8_SA(b, h) + aoff + m * 2048), *(const PG8_LAS i32x4_*)(lds + PG8_SA(b, h) + aoff + m * 2048 + 1024), 0, 1, 2, 3, 4, 5, 6, 7); } \
        else { _Pragma("unroll") for (int m = 0; m < 4; ++m) _Pragma("unroll") for (int k = 0; k < 2; ++k) dst[m][k] = *(const PG8_LAS bf16x8*)(lds + PG8_SA(b, h) + aoff + m * 2048 + k * 1024); } } while (0)
#define PG8_LDB(dst, b, h) do { if constexpr (FP8) { _Pragma("unroll") for (int n = 0; n < 2; ++n) dst##8[n] = __builtin_shufflevector(*(const PG8_LAS i32x4_*)(lds + PG8_SB(b, h) + boff + n * 2048), *(const PG8_LAS i32x4_*)(lds + PG8_SB(b, h) + boff + n * 2048 + 1024), 0, 1, 2, 3, 4, 5, 6, 7); } \
        else { _Pragma("unroll") for (int n = 0; n < 2; ++n) _Pragma("unroll") for (int k = 0; k < 2; ++k) dst[n][k] = *(const PG8_LAS bf16x8*)(lds + PG8_SB(b, h) + boff + n * 2048 + k * 1024); } } while (0)
#define PG8_MMA(ai, bj, At, Bt) do { __builtin_amdgcn_s_setprio(1); if constexpr (FP8) { _Pragma("unroll") for (int m = 0; m < 4; ++m) _Pragma("unroll") for (int n = 0; n < 2; ++n) \
            asm volatile("v_mfma_f32_16x16x128_f8f6f4 %0, %1, %2, %0" : "+v"(acc[ai][bj][m][n]) : "v"(Bt##8[n]), "v"(At##8[m])); }     \
        else { _Pragma("unroll") for (int m = 0; m < 4; ++m) _Pragma("unroll") for (int n = 0; n < 2; ++n) _Pragma("unroll") for (int k = 0; k < 2; ++k) \
        acc[ai][bj][m][n] = __builtin_amdgcn_mfma_f32_16x16x32_bf16(Bt[n][k], At[m][k], acc[ai][bj][m][n], 0, 0, 0); } __builtin_amdgcn_s_setprio(0); } while (0)
#define PG8_WAIT_V(n) asm volatile("s_waitcnt vmcnt(" #n ")" ::: "memory")
#define PG8_WAIT_L(n) asm volatile("s_waitcnt lgkmcnt(" #n ")" ::: "memory")
#define PG8_BAR __builtin_amdgcn_s_barrier()
#define PG8_SCHED __builtin_amdgcn_sched_barrier(0)
    Unit cur{}, nxt{}; int ui = 0;
    if (!S.next(0, cur)) return;
    f32x4 acc[2][2][4][2];
#pragma unroll
    for (int a = 0; a < 2; ++a)
#pragma unroll
        for (int b = 0; b < 2; ++b)
#pragma unroll
            for (int m = 0; m < 4; ++m)
#pragma unroll
                for (int n = 0; n < 2; ++n) acc[a][b][m][n] = (f32x4){0.f, 0.f, 0.f, 0.f};
    bf16x8 At[4][2], B0[2][2], B1[2][2]; i32x8_ At8[4], B08[2], B18[2];
    if constexpr (Sched::GATHER) S.offsets(0, tid, K, voC);
    const char* cA = (const char*)g.A + (size_t)S.a_tile(cur) * tstep + S.k_off(cur); const char* cB = (const char*)g.Bt + (size_t)cur.bn * tstep + S.k_off(cur);
    S.a_ready(cur);
    if constexpr (SP2) {
        PG8_STAGE(PG8_SB(0, 0), cB, voffB); PG8_STAGE(PG8_SB(0, 1), cB + hstep, voffB); PG8_STAGE_A(PG8_SA(0, 0), cA, 0, false); PG8_STAGE_A(PG8_SA(0, 1), cA, 1, false);
        if (wr == 1) PG8_BAR;
        PG8_WAIT_V(2); PG8_BAR;
        PG8_STAGE(PG8_SB(1, 0), cB + kstep, voffB); PG8_STAGE_A(PG8_SA(1, 0), cA + kstep, 0, false); PG8_STAGE(PG8_SB(1, 1), cB + hstep + kstep, voffB);
        PG8_WAIT_V(6); PG8_BAR;
    } else {
        PG8_STAGE(PG8_SB(0, 0), cB, voffB); PG8_STAGE_A(PG8_SA(0, 0), cA, 0, false); PG8_STAGE(PG8_SB(0, 1), cB + hstep, voffB); PG8_STAGE_A(PG8_SA(0, 1), cA, 1, false);
        if (wr == 1) PG8_BAR;
        PG8_WAIT_V(4); PG8_BAR;
        PG8_STAGE(PG8_SB(1, 0), cB + kstep, voffB); PG8_STAGE_A(PG8_SA(1, 0), cA + kstep, 0, false); PG8_STAGE(PG8_SB(1, 1), cB + hstep + kstep, voffB);
        PG8_WAIT_V(6); PG8_BAR;
    }
    for (;;) {
        const bool has_next = S.next(ui + 1, nxt);
        const char* nA = has_next ? (const char*)g.A + (size_t)S.a_tile(nxt) * tstep + S.k_off(nxt) : cA; const char* nB = has_next ? (const char*)g.Bt + (size_t)nxt.bn * tstep + S.k_off(nxt) : cB;
        for (int t = 0; t < nt; t += 2) {
            const bool last = (t == nt - 2);
            const char* a1 = cA + (size_t)(t + 1) * kstep;
            const char* a2 = last ? nA : cA + (size_t)(t + 2) * kstep; const char* b2 = last ? nB : cB + (size_t)(t + 2) * kstep;
            const char* a3 = a2 + kstep; const char* b3 = b2 + kstep;
            const bool nxu = last && has_next;
            if (last && has_next) { S.a_ready(nxt); if constexpr (Sched::GATHER) S.offsets(ui + 1, tid, K, voN); }
            if constexpr (SP2) {
            PG8_LDB(B0, 0, 0); PG8_LDB(B1, 0, 1); PG8_SCHED; PG8_LDA(At, 0, 0); PG8_STAGE_A(PG8_SA(1, 1), a1, 1, false);
            PG8_WAIT_V(8); PG8_WAIT_L(0); PG8_BAR; PG8_MMA(0, 0, At, B0); PG8_MMA(0, 1, At, B1); PG8_BAR; PG8_SCHED;
            PG8_LDA(At, 0, 1); PG8_STAGE(PG8_SB(0, 0), b2, voffB); PG8_STAGE(PG8_SB(0, 1), b2 + hstep, voffB); PG8_STAGE_A(PG8_SA(0, 0), a2, 0, nxu);
            PG8_WAIT_V(8); PG8_WAIT_L(0); PG8_BAR; PG8_MMA(1, 0, At, B0); PG8_MMA(1, 1, At, B1); PG8_BAR; PG8_SCHED;
            PG8_LDB(B0, 1, 0); PG8_LDB(B1, 1, 1); PG8_SCHED; PG8_LDA(At, 1, 0); PG8_STAGE_A(PG8_SA(0, 1), a2, 1, nxu);
            PG8_WAIT_V(8); PG8_WAIT_L(0); PG8_BAR; PG8_MMA(0, 0, At, B0); PG8_MMA(0, 1, At, B1); PG8_BAR; PG8_SCHED;
            PG8_LDA(At, 1, 1); PG8_STAGE(PG8_SB(1, 0), b3, voffB); PG8_STAGE(PG8_SB(1, 1), b3 + hstep, voffB); PG8_STAGE_A(PG8_SA(1, 0), a3, 0, nxu);
            PG8_WAIT_V(8); PG8_WAIT_L(0); PG8_BAR; PG8_MMA(1, 0, At, B0); PG8_MMA(1, 1, At, B1); PG8_BAR; PG8_SCHED;
            } else {
            PG8_LDB(B0, 0, 0); PG8_SCHED; PG8_LDA(At, 0, 0); PG8_STAGE_A(PG8_SA(1, 1), a1, 1, false);
            PG8_WAIT_L(8); PG8_BAR; PG8_WAIT_L(0); PG8_MMA(0, 0, At, B0); PG8_BAR; PG8_SCHED;
            PG8_LDB(B1, 0, 1); PG8_STAGE(PG8_SB(0, 0), b2, voffB);
            PG8_BAR; PG8_WAIT_L(0); PG8_MMA(0, 1, At, B1); PG8_BAR;
            PG8_LDA(At, 0, 1); PG8_STAGE_A(PG8_SA(0, 0), a2, 0, nxu);
            PG8_BAR; PG8_WAIT_L(0); PG8_MMA(1, 0, At, B0); PG8_BAR; PG8_SCHED;
            PG8_STAGE(PG8_SB(0, 1), b2 + hstep, voffB);
            PG8_WAIT_V(6); PG8_BAR; PG8_MMA(1, 1, At, B1); PG8_BAR;
            PG8_LDB(B0, 1, 0); PG8_SCHED; PG8_LDA(At, 1, 0); PG8_STAGE_A(PG8_SA(0, 1), a2, 1, nxu);
            PG8_WAIT_L(8); PG8_BAR; PG8_WAIT_L(0); PG8_MMA(0, 0, At, B0); PG8_BAR; PG8_SCHED;
            PG8_LDB(B1, 1, 1); PG8_STAGE(PG8_SB(1, 0), b3, voffB);
            PG8_BAR; PG8_WAIT_L(0); PG8_MMA(0, 1, At, B1); PG8_BAR;
            PG8_LDA(At, 1, 1); PG8_STAGE_A(PG8_SA(1, 0), a3, 0, nxu);
            PG8_BAR; PG8_WAIT_L(0); PG8_MMA(1, 0, At, B0); PG8_BAR; PG8_SCHED;
            PG8_STAGE(PG8_SB(1, 1), b3 + hstep, voffB);
            PG8_WAIT_V(6); PG8_BAR; PG8_MMA(1, 1, At, B1); PG8_BAR;
            }
        }
        if constexpr (ALIGN_EPI) { if (wr == 0) PG8_BAR; }
        if constexpr (FP8) asm volatile("s_nop 15\n\ts_nop 15" ::: "memory");
        const bool carry = S.carry(cur);
        if constexpr (!Epi::AFTER_DRAIN) { if (!carry) { int lane_e_; asm volatile("v_mbcnt_lo_u32_b32 %0, -1, 0\n\tv_mbcnt_hi_u32_b32 %0, -1, %0" : "=v"(lane_e_));
            E(acc, cur, wr, wc, lane_e_ & 15, lane_e_ >> 4); } S.done(cur); }
        if (!has_next) break;
        if (!carry && !(epi_probe_flags<Epi>::v & 1))
#pragma unroll
        for (int a = 0; a < 2; ++a)
#pragma unroll
            for (int b = 0; b < 2; ++b)
#pragma unroll
                for (int m = 0; m < 4; ++m)
#pragma unroll
                    for (int n = 0; n < 2; ++n) acc[a][b][m][n] = (f32x4){0.f, 0.f, 0.f, 0.f};
        cur = nxt; cA = nA; cB = nB; ++ui;
        if constexpr (Sched::GATHER) { voC[0][0] = voN[0][0]; voC[0][1] = voN[0][1]; voC[1][0] = voN[1][0]; voC[1][1] = voN[1][1]; }
        if constexpr (ALIGN_EPI) { if (wr == 1) PG8_BAR; }
    }
    PG8_WAIT_V(0);
    if constexpr (!ALIGN_EPI) { if (wr == 0) PG8_BAR; }
    PG8_BAR;
    if constexpr (Epi::AFTER_DRAIN) { E.fused(acc, cur, wr, wc, fr, fq, lds, wid, lane); S.done(cur); }
#undef PG8_SA
#undef PG8_SB
#undef PG8_STAGE
#undef PG8_LDA
#undef PG8_LDB
#undef PG8_MMA
#undef PG8_WAIT_V
#undef PG8_WAIT_L
#undef PG8_BAR
#undef PG8_SCHED
}
}

constexpr int D = 1024, NBATCH = 8, SEQ = 4096, CTXL = 256, DEPTH = 2;
constexpr int NLAT = NBATCH * SEQ, NCTX = NBATCH * CTXL, MTOT = NLAT + NCTX;
constexpr int IN_COLS = 5648;
constexpr int ZC = 2560;
constexpr int ZW = 5632;
constexpr int NGC = 3072;
constexpr int ZN = 5888;
constexpr int Z_AB = 0, Z_AC = 256, Z_AX = 512, Z_Q = 768, Z_K = 1280, Z_V = 1408, Z_MQ = 1536, Z_MK = 1792, Z_MV = 2048, Z_MO = 2304, Z_MG = 2560;
constexpr int NEXP = 32, DEXP = 512, PMAX = 77824;
constexpr int NCHUNK = 68, NSCAN = 64;
constexpr float LN_EPS = 1e-6f;
constexpr float WQ_SCALE = 32.0f, WQ_INV = 1.0f / 32.0f;
constexpr float DN_ALPHA = 1.4142135623730951f;
constexpr int NWAVES = 8, NTHREADS = 512;

constexpr size_t MiB = 1u << 20;
constexpr size_t WS_CTL = 0, CTL_ZERO_BYTES = 1 * MiB;
constexpr size_t WS_MOD = 1 * MiB;
constexpr size_t WS_ROPE = 1 * MiB + 512 * 1024;
constexpr size_t WS_GATES = 2 * MiB;
constexpr size_t WS_EID = 5 * MiB;
constexpr size_t WS_WTS = 5 * MiB + 512 * 1024;
constexpr size_t WS_SLOT = 6 * MiB;
constexpr size_t WS_CNT = 6 * MiB + 512 * 1024;
constexpr size_t WS_MG = 7 * MiB;
constexpr size_t WS_NST = 8 * MiB;
constexpr size_t WS_WR = 12 * MiB;
constexpr size_t WS_TOK = 13 * MiB;
constexpr size_t WS_W = 16 * MiB;
constexpr size_t W_IN = 0, W_IN_B = (size_t)ZN * D * 2;
constexpr size_t W_PA = W_IN + W_IN_B, W_PA_B = (size_t)D * 256 * 2;
constexpr size_t W_PB = W_PA + W_PA_B, W_PB_B = (size_t)D * 512 * 2;
constexpr size_t W_PC = W_PB + W_PB_B, W_PC_B = (size_t)D * 256 * 2;
constexpr size_t W_O = W_PC + W_PC_B, W_O_B = (size_t)D * D * 2;
constexpr size_t W_EI = W_O + W_O_B, W_EI_B = (size_t)NEXP * D * D;
constexpr size_t W_EO = W_EI + W_EI_B, W_EO_B = (size_t)NEXP * D * DEXP;
constexpr size_t W_G8 = W_EO + W_EO_B, W_G8_B = (size_t)NGC * D;
constexpr size_t W_O8 = W_G8 + W_G8_B, W_O8_B = (size_t)D * D;
constexpr size_t W_LAYER = W_O8 + W_O8_B;
constexpr size_t WS_H8 = 170 * MiB;
constexpr size_t WS_XA = 240 * MiB;
constexpr size_t WS_XAL = WS_XA + 68 * MiB;
constexpr size_t WS_H = 376 * MiB;
constexpr size_t WS_Z = 444 * MiB;
constexpr size_t WS_GU8 = WS_Z + 170 * MiB;
constexpr size_t WS_XG = WS_Z, WS_ACT = WS_Z + 152 * MiB;
constexpr size_t WS_TOKE = WS_Z + 280 * MiB;
static_assert(WS_GU8 + (size_t)MTOT * 3072 <= WS_TOKE && WS_TOKE + (size_t)32 * MTOT * 4 <= 818 * MiB, "ws map toke");
constexpr size_t WS_YA = 818 * MiB;
constexpr size_t WS_YB = WS_YA + (size_t)MTOT * 256 * 2, WS_YC = WS_YB + (size_t)MTOT * 512 * 2, WS_YL = WS_YA;
constexpr size_t WS_MERGED = 886 * MiB;
constexpr size_t WS_CST = WS_MERGED;
constexpr size_t WS_CSTB = 954 * MiB;
constexpr size_t WS_HLO = 954 * MiB;
constexpr size_t WS_MERGED8 = WS_HLO;
constexpr size_t WS_END = 1022 * MiB;
static_assert(WS_NST + (size_t)NSCAN * NCHUNK * 64 * 4 <= WS_WR && WS_WR + 2 * 2 * 48 * 1024 * 2 <= WS_W && WS_MG + 3 * NSCAN * NCHUNK * 4 <= WS_NST && WS_GATES + (size_t)MTOT * 16 * 4 <= WS_EID, "ws map 0");
static_assert(WS_W + 2 * W_LAYER <= WS_H8 && WS_H8 + (size_t)MTOT * D <= WS_XA && WS_XA + (size_t)MTOT * D * 4 <= WS_H && WS_H + (size_t)MTOT * D * 2 <= WS_Z && WS_Z + (size_t)MTOT * ZC * 2 <= WS_GU8 && WS_GU8 + (size_t)MTOT * NGC <= WS_YA, "ws map 1");
static_assert(WS_YC + (size_t)MTOT * 256 * 2 <= WS_MERGED && WS_MERGED + (size_t)MTOT * D * 2 <= WS_HLO && WS_HLO + (size_t)MTOT * D * 2 <= WS_END && WS_CST + (size_t)NSCAN * NCHUNK * 4096 * 4 <= WS_END, "ws map 2");
static_assert(WS_ACT + (size_t)PMAX * DEXP * 2 <= WS_YA && WS_XG + (size_t)PMAX * D * 2 <= WS_ACT, "ws map 3");
constexpr int CW_BAR = 4096;
constexpr int CW_CNTG = 64;

constexpr int LDS_BYTES = 163840;
constexpr int LDS_RW = 0;
constexpr int LDS_SMALL = 147456;
constexpr int LDS_HIST = LDS_SMALL;
constexpr int LDS_TOT = LDS_SMALL + 128, LDS_BELOW = LDS_SMALL + 256, LDS_BASE = LDS_SMALL + 384, LDS_FILL = LDS_SMALL + 512;
constexpr int LDS_BIAS = LDS_SMALL + 640;
constexpr int LDS_TILE_E = LDS_SMALL + 1024;
constexpr int LDS_PAIRS = LDS_SMALL + 2560;
constexpr int LDS_TOKTAB = LDS_SMALL + 5120;
constexpr int LDS_MISC = LDS_BYTES - 128;

#define GAS __attribute__((address_space(1)))
#define LAS __attribute__((address_space(3)))
typedef unsigned short bf16;
typedef unsigned v4u __attribute__((ext_vector_type(4)));
typedef unsigned v2u __attribute__((ext_vector_type(2)));
typedef float f32x4 __attribute__((ext_vector_type(4)));
typedef float f32x16 __attribute__((ext_vector_type(16)));
typedef short bf16x8 __attribute__((ext_vector_type(8)));
typedef short s16x4 __attribute__((ext_vector_type(4)));
typedef GAS unsigned gu32;
#define RLX_AGENT __ATOMIC_RELAXED, __HIP_MEMORY_SCOPE_AGENT
#define LDS_WAIT() asm volatile("s_waitcnt lgkmcnt(0)" ::: "memory")
#define VM_WAIT() asm volatile("s_waitcnt vmcnt(0)" ::: "memory")
__device__ __forceinline__ unsigned pk2(float lo, float hi) { unsigned r; asm("v_cvt_pk_bf16_f32 %0, %1, %2" : "=v"(r) : "v"(lo), "v"(hi)); return r; }
__device__ __forceinline__ float bflo(unsigned w) { return __uint_as_float(w << 16); }
__device__ __forceinline__ float bfhi(unsigned w) { return __uint_as_float(w & 0xffff0000u); }
__device__ __forceinline__ float bf2f(bf16 b) { return __uint_as_float((unsigned)b << 16); }
__device__ __forceinline__ float fsig(float x) { return __builtin_amdgcn_rcpf(1.0f + __expf(-x)); }
__device__ __forceinline__ float dpp_f(float v, const int ctrl_sel) {
    const int x = __builtin_bit_cast(int, v); int r;
    switch (ctrl_sel) { case 0: r = __builtin_amdgcn_update_dpp(x, x, 0xB1, 0xF, 0xF, false); break;
                        case 1: r = __builtin_amdgcn_update_dpp(x, x, 0x4E, 0xF, 0xF, false); break;
                        case 2: r = __builtin_amdgcn_update_dpp(x, x, 0x141, 0xF, 0xF, false); break;
                        default: r = __builtin_amdgcn_update_dpp(x, x, 0x140, 0xF, 0xF, false); break; }
    return __builtin_bit_cast(float, r);
}
__device__ __forceinline__ float rl_f(float v, int lane) { return __builtin_bit_cast(float, __builtin_amdgcn_readlane(__builtin_bit_cast(int, v), lane)); }
__device__ __forceinline__ float wave_sum(float v) {
    v += dpp_f(v, 0); v += dpp_f(v, 1); v += dpp_f(v, 2); v += dpp_f(v, 3);
    return (rl_f(v, 0) + rl_f(v, 16)) + (rl_f(v, 32) + rl_f(v, 48));
}
__device__ __forceinline__ float wave_max(float v) {
    v = fmaxf(v, dpp_f(v, 0)); v = fmaxf(v, dpp_f(v, 1)); v = fmaxf(v, dpp_f(v, 2)); v = fmaxf(v, dpp_f(v, 3));
    return fmaxf(fmaxf(rl_f(v, 0), rl_f(v, 16)), fmaxf(rl_f(v, 32), rl_f(v, 48)));
}
__device__ __forceinline__ bf16x8 tr_frag(const LAS bf16* plo, const LAS bf16* phi) {
    const s16x4 lo = __builtin_amdgcn_ds_read_tr16_b64_v4i16((LAS s16x4*)plo), hi = __builtin_amdgcn_ds_read_tr16_b64_v4i16((LAS s16x4*)phi);
    return (bf16x8){lo[0], lo[1], lo[2], lo[3], hi[0], hi[1], hi[2], hi[3]};
}
#define MFMA32(a, b, c) __builtin_amdgcn_mfma_f32_32x32x16_bf16((a), (b), (c), 0, 0, 0)

struct Frame {
    LAS unsigned char* lds;
    int tid, lane, wave, G, bid;
    const float* const* in;
    float* out; unsigned char* ws;
};
enum { I_X = 0, I_C, I_CTX, I_CCTX, I_WADA, I_BADA, I_WIN, I_CONVW, I_SINK, I_GATEB, I_NORMW, I_WPA, I_WPB, I_WPC, I_WOUT, I_LN1G, I_LN1B, I_WRG, I_BRG, I_WRE, I_BRE, I_WEI, I_WEO, I_LN2G, I_LN2B };

__device__ __forceinline__ void p0_transpose_item(const float* W, int ldw, int K, int c0, int k0, bf16* WT, int r0, LAS float* scr, int lane) {
    f32x4 tv[16];
#pragma unroll
    for (int i = 0; i < 16; ++i) tv[i] = *(const f32x4*)(W + (size_t)(k0 + 4 * i + (lane >> 4)) * ldw + c0 + 4 * (lane & 15));
#pragma unroll
    for (int i = 0; i < 16; ++i) { LAS float* w = scr + (4 * i + (lane >> 4)) * 65 + 4 * (lane & 15); w[0] = tv[i].x; w[1] = tv[i].y; w[2] = tv[i].z; w[3] = tv[i].w; }
    LDS_WAIT(); asm volatile("" ::: "memory");
    const int c = lane >> 3;
#pragma unroll
    for (int j = 0; j < 8; ++j) { const int n = (lane & 7) + 8 * j; const LAS float* s = scr + (8 * c) * 65 + n;
        v4u o; o.x = pk2(s[0 * 65], s[1 * 65]); o.y = pk2(s[2 * 65], s[3 * 65]); o.z = pk2(s[4 * 65], s[5 * 65]); o.w = pk2(s[6 * 65], s[7 * 65]);
        *(GAS v4u*)(WT + (size_t)(r0 + n) * K + k0 + 8 * c) = o; }
    LDS_WAIT(); asm volatile("" ::: "memory");
}

#ifdef FP8_SELFTEST
typedef int v8i_t __attribute__((ext_vector_type(8)));
#ifndef FP8_BROKEN
#define FP8_BROKEN 0
#endif
__device__ __forceinline__ unsigned fp8_of_small(int v) { return v == 0 ? 0x00u : (v == 1 ? 0x38u : (v == 2 ? 0x40u : 0x44u)); }
__device__ __forceinline__ unsigned st_h(unsigned x) { x *= 2654435761u; x ^= x >> 15; x *= 2246822519u; x ^= x >> 13; return x; }
__device__ __forceinline__ int st_a(int r, int g, int i) { return (int)(st_h((unsigned)(r * 131 + g * 17 + i * 3 + 1)) & 3u); }
__device__ __forceinline__ int st_b(int c, int g, int i) { return (int)(st_h((unsigned)(c * 113 + g * 29 + i * 7 + 5)) & 3u); }
__device__ __forceinline__ bool fp8_selftest(int lane) {
    const int rc = lane & 15, g = lane >> 4;
    v8i_t A, B;
#pragma unroll
    for (int d = 0; d < 8; ++d) { unsigned wa = 0u, wb = 0u;
#pragma unroll
        for (int b = 0; b < 4; ++b) { const int i = 4 * d + b; wa |= fp8_of_small(st_a(rc, g, i)) << (8 * b); wb |= fp8_of_small(st_b(rc, FP8_BROKEN ? (g ^ 1) : g, i)) << (8 * b); }
        A[d] = (int)wa; B[d] = (int)wb; }
    f32x4 c = {0.f, 0.f, 0.f, 0.f};
    c = __builtin_amdgcn_mfma_scale_f32_16x16x128_f8f6f4(A, B, c, 0, 0, 0, FP8_SELFTEST, 0, FP8_SELFTEST);
    bool ok = true;
#pragma unroll
    for (int q = 0; q < 4; ++q) { const int r = 4 * g + q, col = rc; int s = 0;
        for (int gg = 0; gg < 4; ++gg) for (int i = 0; i < 32; ++i) s += st_a(r, gg, i) * st_b(col, gg, i);
        ok = ok && (c[q] == (float)s); }
#ifdef FP8_FORCEFAIL
    ok = false;
#endif
    return __all(ok);
}
#endif
__device__ __forceinline__ void p0_transpose_item8(const float* W, int ldw, int K, int c0, int k0, unsigned char* WT, int r0, LAS float* scr, int lane, int mode = 0) {
    f32x4 tv[16];
#pragma unroll
    for (int i = 0; i < 16; ++i) tv[i] = (mode == 2) ? (f32x4){1.f, 2.f, 3.f, (float)(lane + i)} : *(const f32x4*)(W + (size_t)(k0 + 4 * i + (lane >> 4)) * ldw + c0 + 4 * (lane & 15));
#pragma unroll
    for (int i = 0; i < 16; ++i) { LAS float* w = scr + (4 * i + (lane >> 4)) * 65 + 4 * (lane & 15); w[0] = tv[i].x; w[1] = tv[i].y; w[2] = tv[i].z; w[3] = tv[i].w; }
    LDS_WAIT(); asm volatile("" ::: "memory");
    const int c = lane >> 3;
#pragma unroll
    for (int j = 0; j < 8; ++j) { const int n = (lane & 7) + 8 * j; const LAS float* s = scr + (8 * c) * 65 + n;
        int lo = 0, hi = 0;
        lo = __builtin_amdgcn_cvt_pk_fp8_f32(s[0 * 65] * WQ_SCALE, s[1 * 65] * WQ_SCALE, lo, false); lo = __builtin_amdgcn_cvt_pk_fp8_f32(s[2 * 65] * WQ_SCALE, s[3 * 65] * WQ_SCALE, lo, true);
        hi = __builtin_amdgcn_cvt_pk_fp8_f32(s[4 * 65] * WQ_SCALE, s[5 * 65] * WQ_SCALE, hi, false); hi = __builtin_amdgcn_cvt_pk_fp8_f32(s[6 * 65] * WQ_SCALE, s[7 * 65] * WQ_SCALE, hi, true);
        v2u o; o.x = (unsigned)lo; o.y = (unsigned)hi;
        if (mode == 0) *(GAS v2u*)(WT + (size_t)(r0 + n) * K + k0 + 8 * c) = o; else asm volatile("" :: "v"(o.x), "v"(o.y)); }
    LDS_WAIT(); asm volatile("" ::: "memory");
}
__device__ __forceinline__ void p0_prologue(Frame& F, int mode = 0) {
    {
        LAS float* sv = (LAS float*)(F.lds);
        LAS float* red = (LAS float*)(F.lds + 9 * 1024 * 4);
        bool have = false;
        for (int u = F.bid; u < ((mode == 4) ? 0 : 256); u += F.G) {
            const int layer = u >> 7, cb = (u & 127) * 48, c4 = (F.tid & 15) * 4, kg = F.tid >> 4; const bool act = (F.tid & 15) < 12;
            const float* W = F.in[I_WADA] + (size_t)layer * D * 6144 + cb + (act ? c4 : 0) + (size_t)(kg * 32) * 6144;
            f32x4 w[32];
#pragma unroll
            for (int i = 0; i < 32; ++i) w[i] = *(const f32x4*)(W + (size_t)i * 6144);
            if (!have) {
                for (int i = F.tid; i < 9 * 1024; i += NTHREADS) { const int v = i >> 10, k = i & 1023; const float c = (v < 8) ? F.in[I_C][v * 1024 + k] : F.in[I_CCTX][k]; sv[i] = c / (1.0f + __expf(-c)); }
                have = true; __syncthreads();
            }
            f32x4 acc[9];
#pragma unroll
            for (int v = 0; v < 9; ++v) acc[v] = (f32x4){0.f, 0.f, 0.f, 0.f};
#pragma unroll
            for (int i = 0; i < 32; ++i)
#pragma unroll
                for (int v = 0; v < 9; ++v) acc[v] += sv[v * 1024 + kg * 32 + i] * w[i];
            if (act) {
#pragma unroll
                for (int v = 0; v < 9; ++v) *(LAS f32x4*)(red + (kg * 9 + v) * 48 + c4) = acc[v]; }
            __syncthreads();
            for (int i = F.tid; i < 9 * 48; i += NTHREADS) { const int v = i / 48, c = i % 48; float s = 0.f;
#pragma unroll
                for (int g = 0; g < 32; ++g) s += red[(g * 9 + v) * 48 + c];
                const int gc = cb + c; s += F.in[I_BADA][layer * 6144 + gc];
                ((float*)(F.ws + WS_MOD))[((size_t)(layer * 9 + v) * 6 + (gc >> 10)) * 1024 + (gc & 1023)] = s; }
            __syncthreads();
        }
        __syncthreads();
    }
#ifdef FP8_SELFTEST
    if (F.bid == 0 && F.wave == 0) { const bool ok = fp8_selftest(F.lane); if (!ok && F.lane == 0) ((unsigned*)(F.ws + WS_CTL))[8] = 1u; }
    __syncthreads();
#endif
    if (F.bid == F.G - 1 && F.tid < 16) {
        const int f = F.tid; const double r = 1.0 / sqrt(sqrt(10.0));
        double th = 1.0; for (int i = 0; i < f; ++i) th *= r;
        double c1 = 1.0, s1 = 0.0; { double term = 1.0; const double t2 = th * th; c1 = 0.0; s1 = 0.0; double ct = 1.0, st = th;
            for (int n = 0; n < 14; ++n) { c1 += ct; s1 += st; ct = -ct * t2 / (double)((2 * n + 1) * (2 * n + 2)); st = -st * t2 / (double)((2 * n + 2) * (2 * n + 3)); } (void)term; }
        double c = 1.0, s = 0.0; float* rc = (float*)(F.ws + WS_ROPE); float* rs = rc + 1024;
        for (int p = 0; p < 64; ++p) { rc[p * 16 + f] = (float)c; rs[p * 16 + f] = (float)s; const double cn = c * c1 - s * s1, sn = s * c1 + c * s1; c = cn; s = sn; }
    }
    {
        LAS float* scr = (LAS float*)(F.lds + F.wave * 17408);
        const int gw = F.bid * NWAVES + F.wave, NGW = F.G * NWAVES;
        constexpr int I_G8 = 16 * 48, I_O8 = 16 * 16, I_IN1 = 16 * 40, I_A = 4 * 16, I_B = 8 * 16, I_C2 = 4 * 16, I_EI = NEXP * 16 * 16, I_EO = NEXP * 8 * 16;
        constexpr int PER_LAYER = I_G8 + I_O8 + I_IN1 + I_A + I_B + I_C2 + I_EI + I_EO;
        for (int it = gw; it < ((mode == 3) ? 0 : 2 * PER_LAYER); it += NGW) {
            const int layer = it / PER_LAYER; int r = it % PER_LAYER;
            unsigned char* wl = F.ws + WS_W + (size_t)layer * W_LAYER;
            if (r < I_G8) { const int kb = r / 48, nb = r % 48; p0_transpose_item8(F.in[I_WIN] + (size_t)layer * D * IN_COLS, IN_COLS, D, 2576 + 64 * nb, 64 * kb, (unsigned char*)(wl + W_G8), 64 * nb, scr, F.lane); continue; } r -= I_G8;
            if (r < I_O8) { const int kb = r / 16, nb = r % 16; p0_transpose_item8(F.in[I_WOUT] + (size_t)layer * D * D, D, D, 64 * nb, 64 * kb, (unsigned char*)(wl + W_O8), 64 * nb, scr, F.lane); continue; } r -= I_O8;
            if (r < I_IN1) { const int kb = r / 40, nb = r % 40; p0_transpose_item(F.in[I_WIN] + (size_t)layer * D * IN_COLS, IN_COLS, D, 64 * nb, 64 * kb, (bf16*)(wl + W_IN), 64 * nb, scr, F.lane); continue; } r -= I_IN1;
            if (r < I_A) { const int kb = r / 16, nb = r % 16; p0_transpose_item(F.in[I_WPA] + (size_t)layer * 256 * D, D, 256, 64 * nb, 64 * kb, (bf16*)(wl + W_PA), 64 * nb, scr, F.lane); continue; } r -= I_A;
            if (r < I_B) { const int kb = r / 16, nb = r % 16;
                p0_transpose_item(F.in[I_WPB] + (size_t)layer * 512 * D + (size_t)(kb >> 2) * 256 * D, D, 256, 64 * nb, 64 * (kb & 3), (bf16*)(wl + W_PB) + (size_t)(kb >> 2) * D * 256, 64 * nb, scr, F.lane); continue; } r -= I_B;
            if (r < I_C2) { const int kb = r / 16, nb = r % 16; p0_transpose_item(F.in[I_WPC] + (size_t)layer * 256 * D, D, 256, 64 * nb, 64 * kb, (bf16*)(wl + W_PC), 64 * nb, scr, F.lane); continue; } r -= I_C2;
            if (r < I_EI) { const int e = r / 256, q = r % 256, kb = q / 16, nb = q % 16, n0 = 64 * nb;
                const int s = n0 >> 9, pn = (n0 & 511) >> 7, i0 = n0 & 127;
                p0_transpose_item8(F.in[I_WEI] + ((size_t)layer * NEXP + e) * D * D, D, D, n0, 64 * kb, (unsigned char*)(wl + W_EI) + (size_t)e * D * D, 256 * pn + 128 * s + i0, scr, F.lane, mode); continue; } r -= I_EI;
            { const int e = r / 128, q = r % 128, kb = q / 16, nb = q % 16;
                p0_transpose_item8(F.in[I_WEO] + ((size_t)layer * NEXP + e) * DEXP * D, D, DEXP, 64 * nb, 64 * kb, (unsigned char*)(wl + W_EO) + (size_t)e * D * DEXP, 64 * nb, scr, F.lane, mode); }
        }
        for (int i = F.bid * NTHREADS + F.tid; i < 2 * 48 * 1024; i += F.G * NTHREADS) {
            const int layer = i / (48 * 1024), q = i % (48 * 1024), n = q >> 10, k = q & 1023;
            float w = 0.f; if (n < 4) w = F.in[I_WRG][((size_t)layer * D + k) * 4 + n]; else if (n < 36) w = F.in[I_WRE][((size_t)layer * D + k) * 32 + (n - 4)];
            const unsigned hi = pk2(w, 0.f) & 0xffffu; const float lo = w - __uint_as_float(hi << 16);
            bf16* wr = (bf16*)(F.ws + WS_WR) + (size_t)layer * 2 * 48 * 1024;
            wr[n * 1024 + k] = (bf16)hi; wr[48 * 1024 + n * 1024 + k] = (bf16)(pk2(lo, 0.f) & 0xffffu);
        }
        for (int i = F.bid * NTHREADS + F.tid; i < 2 * 256 * 128; i += F.G * NTHREADS) {
            const int layer = i / (256 * 128), q = i % (256 * 128), n = q >> 7, k0 = (q & 127) * 8;
            v4u o = {0u, 0u, 0u, 0u};
            if (n < 16) { const float* w = F.in[I_WIN] + (size_t)layer * D * IN_COLS + 2560 + n;
                o.x = pk2(w[(size_t)(k0 + 0) * IN_COLS], w[(size_t)(k0 + 1) * IN_COLS]); o.y = pk2(w[(size_t)(k0 + 2) * IN_COLS], w[(size_t)(k0 + 3) * IN_COLS]);
                o.z = pk2(w[(size_t)(k0 + 4) * IN_COLS], w[(size_t)(k0 + 5) * IN_COLS]); o.w = pk2(w[(size_t)(k0 + 6) * IN_COLS], w[(size_t)(k0 + 7) * IN_COLS]); }
            *(v4u*)((bf16*)(F.ws + WS_W + (size_t)layer * W_LAYER + W_IN) + (size_t)(5632 + n) * D + k0) = o;
        }
    }
}

__device__ __forceinline__ void row_load(const float* p, int lane, f32x4 (&v)[4]) {
#pragma unroll
    for (int j = 0; j < 4; ++j) v[j] = ((const f32x4*)p)[lane + 64 * j];
}
__device__ __forceinline__ void row_stats(const f32x4 (&v)[4], float& mean, float& rstd) {
    float s = 0.f;
#pragma unroll
    for (int j = 0; j < 4; ++j) s += (v[j].x + v[j].y) + (v[j].z + v[j].w);
    mean = wave_sum(s) * (1.f / D); float q = 0.f;
#pragma unroll
    for (int j = 0; j < 4; ++j) { const f32x4 d = v[j] - mean; q += (d.x * d.x + d.y * d.y) + (d.z * d.z + d.w * d.w); }
    rstd = 1.0f / sqrtf(wave_sum(q) * (1.f / D) + LN_EPS);
}
__device__ __forceinline__ void row_store_bf16(bf16* p, int lane, const f32x4 (&v)[4]) {
#pragma unroll
    for (int j = 0; j < 4; ++j) { v2u o; o.x = pk2(v[j].x, v[j].y); o.y = pk2(v[j].z, v[j].w); ((v2u*)p)[lane + 64 * j] = o; }
}
__device__ __forceinline__ void row_store_fp8(unsigned char* p, int lane, const f32x4 (&v)[4]) {
#pragma unroll
    for (int j = 0; j < 4; ++j) { int q8 = 0; q8 = __builtin_amdgcn_cvt_pk_fp8_f32(v[j].x, v[j].y, q8, false); q8 = __builtin_amdgcn_cvt_pk_fp8_f32(v[j].z, v[j].w, q8, true); ((unsigned*)p)[lane + 64 * j] = (unsigned)q8; }
}
__device__ __forceinline__ const float* mod_ptr(const Frame& F, int layer, int vec, int part) { return (const float*)(F.ws + WS_MOD) + ((size_t)(layer * 9 + vec) * 6 + part) * 1024; }
__device__ __forceinline__ int row_vec(int row) { return row < NLAT ? (row >> 12) : 8; }
__device__ __forceinline__ void row_modulate(f32x4 (&v)[4], const float* shift, const float* scale, int lane) {
    float mean, rstd; row_stats(v, mean, rstd);
#pragma unroll
    for (int j = 0; j < 4; ++j) { const f32x4 sh = ((const f32x4*)shift)[lane + 64 * j], sc = ((const f32x4*)scale)[lane + 64 * j]; v[j] = (v[j] - mean) * rstd * (sc + 1.0f) + sh; }
}
typedef float f32x4m __attribute__((ext_vector_type(4)));
__device__ __forceinline__ void xa_store(unsigned char* ws, int row, int lane, int j, const f32x4 v) {
    const unsigned b0 = __float_as_uint(v.x) + 0x80u, b1 = __float_as_uint(v.y) + 0x80u, b2 = __float_as_uint(v.z) + 0x80u, b3 = __float_as_uint(v.w) + 0x80u;
    v2u h; h.x = (b0 >> 16) | (b1 & 0xffff0000u); h.y = (b2 >> 16) | (b3 & 0xffff0000u);
    const unsigned l = ((b0 >> 8) & 0xffu) | (b1 & 0xff00u) | ((b2 << 8) & 0xff0000u) | ((b3 << 16) & 0xff000000u);
    ((v2u*)(ws + WS_XA + (size_t)row * (D * 2)))[lane + 64 * j] = h; ((unsigned*)(ws + WS_XAL + (size_t)row * D))[lane + 64 * j] = l;
}
__device__ __forceinline__ f32x4 xa_load_raw(const unsigned char* ws, int row, int lane, int j) {
    const v2u h = ((const v2u*)(ws + WS_XA + (size_t)row * (D * 2)))[lane + 64 * j]; const unsigned l = ((const unsigned*)(ws + WS_XAL + (size_t)row * D))[lane + 64 * j];
    return (f32x4){__uint_as_float(h.x), __uint_as_float(h.y), __uint_as_float(l), 0.f};
}
__device__ __forceinline__ f32x4 xa_decode(const f32x4 r) {
    const unsigned hx = __float_as_uint(r.x), hy = __float_as_uint(r.y), l = __float_as_uint(r.z);
    return (f32x4){__uint_as_float((hx << 16) | ((l & 0xffu) << 8)), __uint_as_float((hx & 0xffff0000u) | (l & 0xff00u)), __uint_as_float((hy << 16) | ((l >> 8) & 0xff00u)), __uint_as_float((hy & 0xffff0000u) | ((l >> 16) & 0xff00u))};
}
__device__ __forceinline__ void gate_rows_mfma(Frame& F, int layer_w, int wg, int rpw) {
    VM_WAIT(); __syncthreads();
    const bf16* H = (const bf16*)(F.ws + WS_H); const bf16* Wg = (const bf16*)(F.ws + WS_W + (size_t)layer_w * W_LAYER + W_IN) + (size_t)ZW * D;
    float* GT = (float*)(F.ws + WS_GATES);
    const int ntile = (rpw + 15) >> 4, l15 = F.lane & 15, lq = F.lane >> 4;
    for (int t = F.wave; t < ntile; t += NWAVES) {
        int arow = 16 * t + l15; if (arow >= rpw) arow = rpw - 1;
        const bf16* ah = H + (size_t)(wg * rpw + arow) * D + 8 * lq; const bf16* bh = Wg + (size_t)l15 * D + 8 * lq;
        f32x4m acc = (f32x4m){0.f, 0.f, 0.f, 0.f};
#pragma unroll 8
        for (int ks = 0; ks < 32; ++ks) acc = __builtin_amdgcn_mfma_f32_16x16x32_bf16(*(const bf16x8*)(ah + 32 * ks), *(const bf16x8*)(bh + 32 * ks), acc, 0, 0, 0);
#pragma unroll
        for (int q = 0; q < 4; ++q) { const int r = 16 * t + 4 * lq + q; if (r < rpw) GT[(size_t)(wg * rpw + r) * 16 + l15] = acc[q]; }
    }
}
__device__ __forceinline__ int seg_split(int row_first, int rpw) {
    if (row_first < NLAT) { const int bnd = ((row_first >> 12) + 1) << 12; if (bnd < row_first + rpw) return bnd - row_first; }
    return rpw;
}
__device__ __forceinline__ int seg_first(int rlo, int wave) { return rlo + ((((wave - rlo) % NWAVES) + NWAVES) % NWAVES); }
__device__ __forceinline__ void ln0_phase(Frame& F) {
    const int rpw = MTOT / 256;
    for (int wg = F.bid; wg < 256; wg += F.G) {
        const int row_first = wg * rpw, rsplit = seg_split(row_first, rpw);
        for (int seg = 0; seg < 2; ++seg) {
            const int rlo = seg ? rsplit : 0, rhi = seg ? rpw : rsplit; if (rlo >= rhi) continue;
            const int vec = row_vec(row_first + rlo); const float* sh = mod_ptr(F, 0, vec, 0); const float* sc = mod_ptr(F, 0, vec, 1);
            f32x4 vsh[4], vsc[4];
#pragma unroll
            for (int j = 0; j < 4; ++j) { vsh[j] = ((const f32x4*)sh)[F.lane + 64 * j]; vsc[j] = ((const f32x4*)sc)[F.lane + 64 * j] + 1.0f; }
            int r = seg_first(rlo, F.wave);
            f32x4 nx[4];
            if (r < rhi) { const int row = row_first + r; row_load(row < NLAT ? F.in[I_X] + (size_t)row * D : F.in[I_CTX] + (size_t)(row - NLAT) * D, F.lane, nx); }
            for (; r < rhi; r += NWAVES) {
                const int row = row_first + r; f32x4 v[4];
#pragma unroll
                for (int j = 0; j < 4; ++j) v[j] = nx[j];
                if (r + NWAVES < rhi) { const int row2 = row + NWAVES; row_load(row2 < NLAT ? F.in[I_X] + (size_t)row2 * D : F.in[I_CTX] + (size_t)(row2 - NLAT) * D, F.lane, nx); }
                float mean, rstd; row_stats(v, mean, rstd);
#pragma unroll
                for (int j = 0; j < 4; ++j) v[j] = (v[j] - mean) * rstd * vsc[j] + vsh[j];
                row_store_bf16((bf16*)(F.ws + WS_H) + (size_t)row * D, F.lane, v); row_store_fp8((unsigned char*)(F.ws + WS_H8) + (size_t)row * D, F.lane, v);
            }
        }
        gate_rows_mfma(F, 0, wg, rpw);
    }
}
__device__ __forceinline__ void ln1_phase(Frame& F, int layer, int M) {
    const int rpw = M / 256;
    LAS int* hist = (LAS int*)(F.lds + LDS_HIST); LAS int* base = (LAS int*)(F.lds + LDS_BASE); LAS int* pairs = (LAS int*)(F.lds + LDS_PAIRS);
    LAS float* bias = (LAS float*)(F.lds + LDS_BIAS);
    LAS float* LG = (LAS float*)(F.lds + F.wave * 4096);
    if (F.tid < 4) bias[F.tid] = F.in[I_BRG][layer * 4 + F.tid]; else if (F.tid < 36) bias[F.tid] = F.in[I_BRE][layer * 32 + F.tid - 4];
    const float* g1 = F.in[I_LN1G] + layer * D; const float* b1 = F.in[I_LN1B] + layer * D;
    const bf16* WRh = (const bf16*)(F.ws + WS_WR) + (size_t)layer * 2 * 48 * 1024; const bf16* WRl = WRh + 48 * 1024;
    bf16* HLO = (bf16*)(F.ws + WS_HLO);
    for (int wg = F.bid; wg < 256; wg += F.G) {
        if (F.tid < 32) hist[F.tid] = 0;
        {
        const int row_first = wg * rpw, rsplit = seg_split(row_first, rpw);
        f32x4 vg1[4], vb1[4];
#pragma unroll
        for (int j = 0; j < 4; ++j) { vg1[j] = ((const f32x4*)g1)[F.lane + 64 * j]; vb1[j] = ((const f32x4*)b1)[F.lane + 64 * j]; }
        for (int seg = 0; seg < 2; ++seg) {
            const int rlo = seg ? rsplit : 0, rhi = seg ? rpw : rsplit; if (rlo >= rhi) continue;
            const int vec = row_vec(row_first + rlo); const float* gate = mod_ptr(F, layer, vec, 2); const float* sh = mod_ptr(F, layer, vec, 3); const float* sc = mod_ptr(F, layer, vec, 4);
            f32x4 vgate[4], vsh[4], vsc[4];
#pragma unroll
            for (int j = 0; j < 4; ++j) { vgate[j] = ((const f32x4*)gate)[F.lane + 64 * j]; vsh[j] = ((const f32x4*)sh)[F.lane + 64 * j]; vsc[j] = ((const f32x4*)sc)[F.lane + 64 * j] + 1.0f; }
#define LN1_XP(rw) ((rw) < NLAT ? F.in[I_X] + (size_t)(rw) * D : F.in[I_CTX] + (size_t)((rw) - NLAT) * D)
#define LN1_LOAD(BX, BY, rw) do { if (layer == 0) row_load(LN1_XP(rw), F.lane, BX); else { _Pragma("unroll") for (int j = 0; j < 4; ++j) BX[j] = xa_load_raw(F.ws, (rw), F.lane, j); } const bf16* yl_ = (const bf16*)(F.ws + WS_YL) + (size_t)(rw) * D; \
                _Pragma("unroll") for (int j = 0; j < 4; ++j) BY[j] = ((const v2u*)yl_)[F.lane + 64 * j]; } while (0)
#define LN1_STEP(BX, BY, rr) do { const int row = row_first + (rr); f32x4 v[4]; v2u y[4]; \
                _Pragma("unroll") for (int j = 0; j < 4; ++j) { v[j] = (layer == 0) ? BX[j] : xa_decode(BX[j]); y[j] = BY[j]; } \
                if ((rr) + 2 * NWAVES < rhi) LN1_LOAD(BX, BY, row + 2 * NWAVES); \
                _Pragma("unroll") for (int j = 0; j < 4; ++j) { const f32x4 g = vgate[j]; \
                    v[j].x = DN_ALPHA * v[j].x + g.x * bflo(y[j].x); v[j].y = DN_ALPHA * v[j].y + g.y * bfhi(y[j].x); v[j].z = DN_ALPHA * v[j].z + g.z * bflo(y[j].y); v[j].w = DN_ALPHA * v[j].w + g.w * bfhi(y[j].y); } \
                float mean, rstd; row_stats(v, mean, rstd); \
                _Pragma("unroll") for (int j = 0; j < 4; ++j) { v[j] = (v[j] - mean) * rstd * vg1[j] + vb1[j]; \
                    xa_store(F.ws, row, F.lane, j, v[j]); } \
                row_stats(v, mean, rstd); \
                _Pragma("unroll") for (int j = 0; j < 4; ++j) { v[j] = (v[j] - mean) * rstd * vsc[j] + vsh[j]; \
                    int q8 = 0; q8 = __builtin_amdgcn_cvt_pk_fp8_f32(v[j].x, v[j].y, q8, false); q8 = __builtin_amdgcn_cvt_pk_fp8_f32(v[j].z, v[j].w, q8, true); \
                    ((unsigned*)((unsigned char*)(F.ws + WS_H8) + (size_t)row * D))[F.lane + 64 * j] = (unsigned)q8; \
                    typedef float f32x2q_ __attribute__((ext_vector_type(2))); const f32x2q_ d01 = __builtin_amdgcn_cvt_pk_f32_fp8(q8, false), d23 = __builtin_amdgcn_cvt_pk_f32_fp8(q8, true); \
                    v2u lo; lo.x = pk2(v[j].x - d01.x, v[j].y - d01.y); lo.y = pk2(v[j].z - d23.x, v[j].w - d23.y);     \
                    ((v2u*)(HLO + (size_t)row * D))[F.lane + 64 * j] = lo; } } while (0)
            int r = seg_first(rlo, F.wave);
            f32x4 ax[4], bx[4]; v2u ay[4], by[4];
            if (r < rhi) LN1_LOAD(ax, ay, row_first + r);
            if (r + NWAVES < rhi) LN1_LOAD(bx, by, row_first + r + NWAVES);
            for (; r < rhi; r += 2 * NWAVES) {
                LN1_STEP(ax, ay, r);
                if (r + NWAVES < rhi) LN1_STEP(bx, by, r + NWAVES);
            }
#undef LN1_STEP
#undef LN1_LOAD
#undef LN1_XP
        }
        }
        VM_WAIT(); __syncthreads();
        const int ntile = (rpw + 15) >> 4, l15 = F.lane & 15, lq = F.lane >> 4;
        for (int t = F.wave; t < ntile; t += NWAVES) {
            int arow = 16 * t + l15; if (arow >= rpw) arow = rpw - 1;
            const unsigned char* ah = (const unsigned char*)(F.ws + WS_H8) + (size_t)(wg * rpw + arow) * D + 8 * lq; const bf16* al = HLO + (size_t)(wg * rpw + arow) * D + 8 * lq;
            const bf16* bh = WRh + (size_t)l15 * D + 8 * lq; const bf16* bl = WRl + (size_t)l15 * D + 8 * lq;
            f32x4m acc[3];
#pragma unroll
            for (int c = 0; c < 3; ++c) acc[c] = (f32x4m){0.f, 0.f, 0.f, 0.f};
#pragma unroll 4
            for (int ks = 0; ks < 32; ++ks) {
                const v2u a8 = *(const v2u*)(ah + 32 * ks); const bf16x8 a_lo = *(const bf16x8*)(al + 32 * ks);
                typedef float f32x2q_ __attribute__((ext_vector_type(2)));
                const f32x2q_ e01 = __builtin_amdgcn_cvt_pk_f32_fp8((int)a8.x, false), e23 = __builtin_amdgcn_cvt_pk_f32_fp8((int)a8.x, true), e45 = __builtin_amdgcn_cvt_pk_f32_fp8((int)a8.y, false), e67 = __builtin_amdgcn_cvt_pk_f32_fp8((int)a8.y, true);
                v4u ah4; ah4.x = pk2(e01.x, e01.y); ah4.y = pk2(e23.x, e23.y); ah4.z = pk2(e45.x, e45.y); ah4.w = pk2(e67.x, e67.y);
                const bf16x8 a_hi = __builtin_bit_cast(bf16x8, ah4);
#pragma unroll
                for (int c = 0; c < 3; ++c) { const bf16x8 b_hi = *(const bf16x8*)(bh + (size_t)c * 16 * D + 32 * ks), b_lo = *(const bf16x8*)(bl + (size_t)c * 16 * D + 32 * ks);
                    acc[c] = __builtin_amdgcn_mfma_f32_16x16x32_bf16(a_lo, b_hi, acc[c], 0, 0, 0);
                    acc[c] = __builtin_amdgcn_mfma_f32_16x16x32_bf16(a_hi, b_lo, acc[c], 0, 0, 0);
                    acc[c] = __builtin_amdgcn_mfma_f32_16x16x32_bf16(a_hi, b_hi, acc[c], 0, 0, 0); }
            }
#pragma unroll
            for (int c = 0; c < 3; ++c)
#pragma unroll
                for (int q = 0; q < 4; ++q) LG[(4 * lq + q) * 48 + 16 * c + l15] = acc[c][q];
            LDS_WAIT();
            if (F.lane < 16 && 16 * t + F.lane < rpw) {
                const int row = wg * rpw + 16 * t + F.lane; const LAS float* lg = LG + F.lane * 48;
                float gl[4];
#pragma unroll
                for (int i = 0; i < 4; ++i) gl[i] = lg[i] + bias[i];
                int gs = 0; float gm = gl[0];
#pragma unroll
                for (int i = 1; i < 4; ++i) if (gl[i] > gm) { gm = gl[i]; gs = i; }
                float gden = 0.f;
#pragma unroll
                for (int i = 0; i < 4; ++i) gden += __expf(gl[i] - gm);
                const float gprob = 1.0f / gden;
                float el[8];
#pragma unroll
                for (int i = 0; i < 8; ++i) el[i] = lg[4 + 8 * gs + i] + bias[4 + 8 * gs + i];
                int i1 = 0; float l1 = el[0];
#pragma unroll
                for (int i = 1; i < 8; ++i) if (el[i] > l1) { l1 = el[i]; i1 = i; }
                int i2 = -1; float l2 = -3.0e38f;
#pragma unroll
                for (int i = 0; i < 8; ++i) if (i != i1 && el[i] > l2) { l2 = el[i]; i2 = i; }
                const float ex = __expf(l2 - l1), p1 = 1.0f / (1.0f + ex), p2 = ex * p1;
                float* wt = (float*)(F.ws + WS_WTS) + (size_t)row * 2; wt[0] = p1 * gprob; wt[1] = p2 * gprob;
                const int e1 = gs * 8 + i1, e2 = gs * 8 + i2;
                const int k1 = atomicAdd((int*)&hist[e1], 1), k2 = atomicAdd((int*)&hist[e2], 1);
                pairs[(16 * t + F.lane) * 2] = e1 | (k1 << 8); pairs[(16 * t + F.lane) * 2 + 1] = e2 | (k2 << 8);
            }
            LDS_WAIT();
        }
        __syncthreads();
        if (F.tid < 32) base[F.tid] = __hip_atomic_fetch_add((int*)(F.ws + WS_CTL) + CW_CNTG + layer * 32 + F.tid, hist[F.tid], RLX_AGENT);
        __syncthreads();
        if (F.tid < 2 * rpw) { const int pr = pairs[F.tid], e = pr & 255, p = base[e] + (pr >> 8), row = wg * rpw + (F.tid >> 1);
            ((int*)(F.ws + WS_SLOT))[(size_t)row * 2 + (F.tid & 1)] = (e << 20) | p; ((int*)(F.ws + WS_TOKE))[(size_t)e * MTOT + p] = row; }
        __syncthreads();
    }
}
__device__ __forceinline__ void ln2_phase(Frame& F, int layer, int M) {
    const int rpw = M / 256; const bool last = (layer == DEPTH - 1);
    const float* g2 = F.in[I_LN2G] + layer * D; const float* b2 = F.in[I_LN2B] + layer * D;
    LAS int* tot = (LAS int*)(F.lds + LDS_TOT); LAS int* base = (LAS int*)(F.lds + LDS_BASE);
    if (F.tid < 32) tot[F.tid] = __hip_atomic_load((int*)(F.ws + WS_CTL) + CW_CNTG + layer * 32 + F.tid, RLX_AGENT);
    __syncthreads();
    if (F.tid < 32) { int ps = 0; for (int e = 0; e < F.tid; ++e) ps += ((tot[e] + 255) >> 8) << 8; base[F.tid] = ps; }
    __syncthreads();
#define LN2_SLOT(q) (base[(q) >> 20] + ((q) & 0xFFFFF))
    const int* SL = (const int*)(F.ws + WS_SLOT); const float* WT = (const float*)(F.ws + WS_WTS); const unsigned char* Y = (const unsigned char*)(F.ws + WS_XG);
    for (int wg = F.bid; wg < 256; wg += F.G) {
        const int row_first = wg * rpw, rsplit = seg_split(row_first, rpw);
        f32x4 vg2[4], vb2[4];
#pragma unroll
        for (int j = 0; j < 4; ++j) { vg2[j] = ((const f32x4*)g2)[F.lane + 64 * j]; vb2[j] = ((const f32x4*)b2)[F.lane + 64 * j]; }
        for (int seg = 0; seg < 2; ++seg) {
            const int rlo = seg ? rsplit : 0, rhi = seg ? rpw : rsplit; if (rlo >= rhi) continue;
            const int vec = row_vec(row_first + rlo); const float* gate = mod_ptr(F, layer, vec, 5);
            f32x4 vgate[4], vsh[4], vsc[4];
#pragma unroll
            for (int j = 0; j < 4; ++j) { vgate[j] = ((const f32x4*)gate)[F.lane + 64 * j]; vsh[j] = vgate[j]; vsc[j] = vgate[j]; }
            if (!last) { const float* sh = mod_ptr(F, layer + 1, vec, 0); const float* sc = mod_ptr(F, layer + 1, vec, 1);
#pragma unroll
                for (int j = 0; j < 4; ++j) { vsh[j] = ((const f32x4*)sh)[F.lane + 64 * j]; vsc[j] = ((const f32x4*)sc)[F.lane + 64 * j] + 1.0f; } }
            int r = seg_first(rlo, F.wave);
            f32x4 nx[4]; unsigned na[4], nb[4]; float nw0 = 0.f, nw1 = 0.f; int s0n = 0, s1n = 0;
            if (r < rhi) { const int row = row_first + r;
#pragma unroll
                for (int j = 0; j < 4; ++j) nx[j] = xa_load_raw(F.ws, row, F.lane, j);
                const int q0 = SL[(size_t)row * 2], q1 = SL[(size_t)row * 2 + 1]; const int s0 = LN2_SLOT(q0), s1 = LN2_SLOT(q1); nw0 = WT[(size_t)row * 2]; nw1 = WT[(size_t)row * 2 + 1];
#pragma unroll
                for (int j = 0; j < 4; ++j) { na[j] = ((const unsigned*)(Y + (size_t)s0 * D))[F.lane + 64 * j]; nb[j] = ((const unsigned*)(Y + (size_t)s1 * D))[F.lane + 64 * j]; }
                if (r + NWAVES < rhi) { s0n = SL[(size_t)(row + NWAVES) * 2]; s1n = SL[(size_t)(row + NWAVES) * 2 + 1]; } }
            for (; r < rhi; r += NWAVES) {
                const int row = row_first + r;
                f32x4 v[4]; unsigned a[4], b[4]; const float w0 = nw0 * (1.0f / 16.0f), w1 = nw1 * (1.0f / 16.0f);
#pragma unroll
                for (int j = 0; j < 4; ++j) { v[j] = xa_decode(nx[j]); a[j] = na[j]; b[j] = nb[j]; }
                if (r + NWAVES < rhi) { const int row2 = row + NWAVES;
#pragma unroll
                    for (int j = 0; j < 4; ++j) nx[j] = xa_load_raw(F.ws, row2, F.lane, j);
                    nw0 = WT[(size_t)row2 * 2]; nw1 = WT[(size_t)row2 * 2 + 1];
#pragma unroll
                    for (int j = 0; j < 4; ++j) { na[j] = ((const unsigned*)(Y + (size_t)LN2_SLOT(s0n) * D))[F.lane + 64 * j]; nb[j] = ((const unsigned*)(Y + (size_t)LN2_SLOT(s1n) * D))[F.lane + 64 * j]; }
                    if (r + 2 * NWAVES < rhi) { s0n = SL[(size_t)(row2 + NWAVES) * 2]; s1n = SL[(size_t)(row2 + NWAVES) * 2 + 1]; } }
#pragma unroll
                for (int j = 0; j < 4; ++j) { const f32x4 g = vgate[j];
                    typedef float f32x2q __attribute__((ext_vector_type(2)));
                    const f32x2q a01 = __builtin_amdgcn_cvt_pk_f32_fp8((int)a[j], false), a23 = __builtin_amdgcn_cvt_pk_f32_fp8((int)a[j], true), b01 = __builtin_amdgcn_cvt_pk_f32_fp8((int)b[j], false), b23 = __builtin_amdgcn_cvt_pk_f32_fp8((int)b[j], true);
                    v[j].x = DN_ALPHA * v[j].x + g.x * (w0 * a01.x + w1 * b01.x); v[j].y = DN_ALPHA * v[j].y + g.y * (w0 * a01.y + w1 * b01.y);
                    v[j].z = DN_ALPHA * v[j].z + g.z * (w0 * a23.x + w1 * b23.x); v[j].w = DN_ALPHA * v[j].w + g.w * (w0 * a23.y + w1 * b23.y); }
                float mean, rstd; row_stats(v, mean, rstd);
#ifdef FP8_SELFTEST
                if (last && ((const unsigned*)(F.ws + WS_CTL))[8] != 0u) { mean = __builtin_nanf(""); }
#endif
#pragma unroll
                for (int j = 0; j < 4; ++j) { v[j] = (v[j] - mean) * rstd * vg2[j] + vb2[j]; if (last) ((f32x4*)(F.out + (size_t)row * D))[F.lane + 64 * j] = v[j]; else xa_store(F.ws, row, F.lane, j, v[j]); }
                if (!last) { row_stats(v, mean, rstd);
#pragma unroll
                    for (int j = 0; j < 4; ++j) v[j] = (v[j] - mean) * rstd * vsc[j] + vsh[j];
                    row_store_bf16((bf16*)(F.ws + WS_H) + (size_t)row * D, F.lane, v); row_store_fp8((unsigned char*)(F.ws + WS_H8) + (size_t)row * D, F.lane, v); }
            }
        }
        if (!last) gate_rows_mfma(F, layer + 1, wg, rpw);
    }
}
#undef LN2_SLOT

__device__ __forceinline__ void unpack8(const v4u w, float (&f)[8]) { f[0] = bflo(w.x); f[1] = bfhi(w.x); f[2] = bflo(w.y); f[3] = bfhi(w.y); f[4] = bflo(w.z); f[5] = bfhi(w.z); f[6] = bflo(w.w); f[7] = bfhi(w.w); }
__device__ __forceinline__ void conv_phase(Frame& F, int layer, int M) {
    const bf16* Z = (const bf16*)(F.ws + WS_Z); bf16* YA = (bf16*)(F.ws + WS_YA);
    const float* cw = F.in[I_CONVW] + layer * 3 * 256;
    const int total = M * 32;
    for (int i = F.bid * NTHREADS + F.tid; i < total; i += F.G * NTHREADS) {
        const int row = i >> 5, c0 = (i & 31) * 8;
        int t, len; if (row < NLAT) { t = row & (SEQ - 1); len = SEQ; } else { t = (row - NLAT) & (CTXL - 1); len = CTXL; }
        const bf16* zr = Z + (size_t)row * ZC;
        float z0[8], a[8], b[8], acc[8];
        unpack8(*(const v4u*)(zr + Z_AB + c0), z0);
        unpack8(*(const v4u*)(zr + Z_AC + c0), a); unpack8(*(const v4u*)(zr + Z_AX + c0), b);
#pragma unroll
        for (int j = 0; j < 8; ++j) acc[j] = cw[256 + c0 + j] * (a[j] * b[j]);
        if (t > 0) { unpack8(*(const v4u*)(zr - ZC + Z_AC + c0), a); unpack8(*(const v4u*)(zr - ZC + Z_AX + c0), b);
#pragma unroll
            for (int j = 0; j < 8; ++j) acc[j] += cw[c0 + j] * (a[j] * b[j]); }
        if (t < len - 1) { unpack8(*(const v4u*)(zr + ZC + Z_AC + c0), a); unpack8(*(const v4u*)(zr + ZC + Z_AX + c0), b);
#pragma unroll
            for (int j = 0; j < 8; ++j) acc[j] += cw[512 + c0 + j] * (a[j] * b[j]); }
        v4u o; o.x = pk2(z0[0] * acc[0], z0[1] * acc[1]); o.y = pk2(z0[2] * acc[2], z0[3] * acc[3]); o.z = pk2(z0[4] * acc[4], z0[5] * acc[5]); o.w = pk2(z0[6] * acc[6], z0[7] * acc[7]);
        *(v4u*)(YA + (size_t)row * 256 + c0) = o;
    }
}

constexpr int KPITCH = 72;
constexpr int VPITCH = 96;
__device__ __forceinline__ void rope8(const v4u own, const v4u par, const float* cs, const float* sn, bool second, v4u& out) {
    float a[8], b[8]; unpack8(own, a); unpack8(par, b); float o[8];
#pragma unroll
    for (int j = 0; j < 8; ++j) o[j] = second ? (a[j] * cs[j] + b[j] * sn[j]) : (a[j] * cs[j] - b[j] * sn[j]);
    out.x = pk2(o[0], o[1]); out.y = pk2(o[2], o[3]); out.z = pk2(o[4], o[5]); out.w = pk2(o[6], o[7]);
}
__device__ __forceinline__ void rope8s(const v4u own, const v4u par, const float* cs, const float* sn, bool second, float scale, v4u& out) {
    float a[8], b[8]; unpack8(own, a); unpack8(par, b); float o[8];
#pragma unroll
    for (int j = 0; j < 8; ++j) o[j] = (second ? (a[j] * cs[j] + b[j] * sn[j]) : (a[j] * cs[j] - b[j] * sn[j])) * scale;
    out.x = pk2(o[0], o[1]); out.y = pk2(o[2], o[3]); out.z = pk2(o[4], o[5]); out.w = pk2(o[6], o[7]);
}
__device__ __forceinline__ void attn_stage_write(LAS bf16* Ks, LAS bf16* Vt, const v4u g_own, const v4u g_par, const v4u g_v, bool win, int kt, int sr, int sc, int sd0, const float* RC, const float* RS) {
    v4u own = g_own;
    if (win) { const int pos = (sc < 4) ? kt : sr, f0 = sd0 & 15; v4u o; rope8(g_own, g_par, RC + pos * 16 + f0, RS + pos * 16 + f0, (sd0 & 16) != 0, o); own = o; }
    *(LAS v4u*)(Ks + sr * KPITCH + sd0) = own;
    *(LAS v4u*)(Vt + sr * VPITCH + sd0) = g_v;
}
__device__ __forceinline__ void attn_unit(Frame& F, int layer, int b, int qb, int kvh, bool ctxq) {
    const bf16* Z = (const bf16*)(F.ws + WS_Z); bf16* YB = (bf16*)(F.ws + WS_YB);
    const float* RC = (const float*)(F.ws + WS_ROPE); const float* RS = RC + 1024;
    constexpr int BUFB = 64 * (KPITCH + VPITCH) * 2;
    const int lane = F.lane, w = F.wave, l31 = lane & 31, hh = lane >> 5;
    const int head = kvh * 4 + (w >> 1), tq0 = qb * 64 + (w & 1) * 32;
    const int qrow = (ctxq ? (NLAT + b * CTXL) : (b * SEQ)) + tq0 + l31, qpos = tq0 + l31;
    constexpr float C2 = 0.125f * 1.4426950408889634f;
    bf16x8 qf[4];
    {
        const bf16* qp = Z + (size_t)qrow * ZC + Z_Q + head * 64 + 8 * hh;
        v4u raw[4];
#pragma unroll
        for (int ks = 0; ks < 4; ++ks) raw[ks] = *(const v4u*)(qp + 16 * ks);
        if (!ctxq) { const int pr = qpos >> 6, pc = qpos & 63; v4u o0, o1, o2, o3;
            rope8s(raw[0], raw[1], RC + pr * 16 + 8 * hh, RS + pr * 16 + 8 * hh, false, C2, o0); rope8s(raw[1], raw[0], RC + pr * 16 + 8 * hh, RS + pr * 16 + 8 * hh, true, C2, o1);
            rope8s(raw[2], raw[3], RC + pc * 16 + 8 * hh, RS + pc * 16 + 8 * hh, false, C2, o2); rope8s(raw[3], raw[2], RC + pc * 16 + 8 * hh, RS + pc * 16 + 8 * hh, true, C2, o3);
            raw[0] = o0; raw[1] = o1; raw[2] = o2; raw[3] = o3; }
        else {
#pragma unroll
            for (int ks = 0; ks < 4; ++ks) { float f[8]; unpack8(raw[ks], f); raw[ks].x = pk2(f[0] * C2, f[1] * C2); raw[ks].y = pk2(f[2] * C2, f[3] * C2); raw[ks].z = pk2(f[4] * C2, f[5] * C2); raw[ks].w = pk2(f[6] * C2, f[7] * C2); } }
#pragma unroll
        for (int ks = 0; ks < 4; ++ks) qf[ks] = __builtin_bit_cast(bf16x8, raw[ks]);
    }
    f32x16 oacc[2];
#pragma unroll
    for (int a = 0; a < 2; ++a)
#pragma unroll
        for (int i = 0; i < 16; ++i) oacc[a][i] = 0.f;
    float mrun = F.in[I_SINK][layer * 8 + head] * 1.4426950408889634f, lrun = 1.f;
    const int wlo = ctxq ? 0 : (qb - 2 < 0 ? 0 : qb - 2), whi = ctxq ? -1 : (qb + 2 > 63 ? 63 : qb + 2);
    const int ntiles = 4 + (whi - wlo + 1);
    const int sr = F.tid >> 3, sc = F.tid & 7, sd0 = 8 * sc;
    v4u g_own, g_par, g_v;
    {   const int krow = NLAT + b * CTXL + sr; const bf16* kp = Z + (size_t)krow * ZC + Z_K + kvh * 64;
        g_own = *(const v4u*)(kp + sd0); g_par = g_own; g_v = *(const v4u*)(Z + (size_t)krow * ZC + Z_V + kvh * 64 + sd0); }
    __syncthreads();
    attn_stage_write((LAS bf16*)(F.lds), (LAS bf16*)(F.lds) + 64 * KPITCH, g_own, g_par, g_v, false, 0, sr, sc, sd0, RC, RS);
    __syncthreads();
    for (int ti = 0; ti < ntiles; ++ti) {
        const bool win = ti >= 4; const int kt = win ? wlo + (ti - 4) : ti;
        LAS bf16* Ks = (LAS bf16*)(F.lds + (ti & 1) * BUFB); LAS bf16* Vt = Ks + 64 * KPITCH;
        const LAS bf16* vtr0 = Vt + (4 * hh + ((lane & 15) >> 2)) * VPITCH + 16 * ((lane >> 4) & 1) + 4 * (lane & 3);
        const bool more = ti + 1 < ntiles; const bool nwin = ti + 1 >= 4; const int nkt = nwin ? wlo + (ti + 1 - 4) : ti + 1;
        if (more) {
            const int krow = (nwin ? (b * SEQ + 64 * nkt) : (NLAT + b * CTXL + 64 * nkt)) + sr; const bf16* kp = Z + (size_t)krow * ZC + Z_K + kvh * 64;
            g_own = *(const v4u*)(kp + sd0); g_par = *(const v4u*)(kp + (sd0 ^ 16)); g_v = *(const v4u*)(Z + (size_t)krow * ZC + Z_V + kvh * 64 + sd0);
        }
        f32x16 s0, s1;
#pragma unroll
        for (int i = 0; i < 16; ++i) { s0[i] = 0.f; s1[i] = 0.f; }
#pragma unroll
        for (int ks = 0; ks < 4; ++ks) { const bf16x8 kf0 = *(const LAS bf16x8*)(Ks + l31 * KPITCH + 16 * ks + 8 * hh), kf1 = *(const LAS bf16x8*)(Ks + (32 + l31) * KPITCH + 16 * ks + 8 * hh);
            s0 = MFMA32(kf0, qf[ks], s0); s1 = MFMA32(kf1, qf[ks], s1); }
        if (win && (kt == qb - 2 || kt == qb + 2)) {
#pragma unroll
            for (int i = 0; i < 16; ++i) { const int kpos = 64 * kt + (i & 3) + 8 * (i >> 2) + 4 * hh; const int d0 = qpos - kpos, d1 = d0 - 32;
                if (d0 > 128 || d0 < -128) s0[i] = -__builtin_inff(); if (d1 > 128 || d1 < -128) s1[i] = -__builtin_inff(); }
        }
        float mx = -3.0e38f;
#pragma unroll
        for (int i = 0; i < 16; ++i) mx = fmaxf(mx, fmaxf(s0[i], s1[i]));
        mx = fmaxf(mx, __shfl_xor(mx, 32));
        const float mnew = fmaxf(mrun, mx);
        if (__any(mnew > mrun)) { const float alpha = __builtin_amdgcn_exp2f(mrun - mnew); lrun *= alpha;
#pragma unroll
            for (int dt = 0; dt < 2; ++dt)
#pragma unroll
                for (int i = 0; i < 16; ++i) oacc[dt][i] *= alpha; }
        mrun = mnew;
        float sum = 0.f;
#pragma unroll
        for (int i = 0; i < 16; ++i) { const float p0 = __builtin_amdgcn_exp2f(s0[i] - mnew), p1 = __builtin_amdgcn_exp2f(s1[i] - mnew); s0[i] = p0; s1[i] = p1; sum += p0 + p1; }
        sum += __shfl_xor(sum, 32);
        lrun += sum;
        bf16x8 pf[2][2];
#pragma unroll
        for (int sp = 0; sp < 2; ++sp) { v4u pk;
            pk.x = pk2(s0[8 * sp + 0], s0[8 * sp + 1]); pk.y = pk2(s0[8 * sp + 2], s0[8 * sp + 3]); pk.z = pk2(s0[8 * sp + 4], s0[8 * sp + 5]); pk.w = pk2(s0[8 * sp + 6], s0[8 * sp + 7]); pf[0][sp] = __builtin_bit_cast(bf16x8, pk);
            pk.x = pk2(s1[8 * sp + 0], s1[8 * sp + 1]); pk.y = pk2(s1[8 * sp + 2], s1[8 * sp + 3]); pk.z = pk2(s1[8 * sp + 4], s1[8 * sp + 5]); pk.w = pk2(s1[8 * sp + 6], s1[8 * sp + 7]); pf[1][sp] = __builtin_bit_cast(bf16x8, pk); }
#pragma unroll
        for (int dt = 0; dt < 2; ++dt)
#pragma unroll
            for (int kt2 = 0; kt2 < 2; ++kt2)
#pragma unroll
                for (int sp = 0; sp < 2; ++sp) { const LAS bf16* vp = vtr0 + (32 * kt2 + 16 * sp) * VPITCH + 32 * dt;
                    oacc[dt] = MFMA32(tr_frag(vp, vp + 8 * VPITCH), pf[kt2][sp], oacc[dt]); }
        if (more) { LAS bf16* Kn = (LAS bf16*)(F.lds + ((ti + 1) & 1) * BUFB); attn_stage_write(Kn, Kn + 64 * KPITCH, g_own, g_par, g_v, nwin, nkt, sr, sc, sd0, RC, RS); }
        __syncthreads();
    }
    { const float inv = 1.0f / lrun; bf16* op = YB + (size_t)(head >> 2) * MTOT * 256 + (size_t)qrow * 256 + (head & 3) * 64 + 4 * hh;
#pragma unroll
        for (int dt = 0; dt < 2; ++dt)
#pragma unroll
            for (int g = 0; g < 4; ++g) { v2u o; o.x = pk2(oacc[dt][4 * g] * inv, oacc[dt][4 * g + 1] * inv); o.y = pk2(oacc[dt][4 * g + 2] * inv, oacc[dt][4 * g + 3] * inv);
                *(v2u*)(op + 32 * dt + 8 * g) = o; } }
}
__device__ __forceinline__ void attn_phase(Frame& F, int layer) {
    const int nlat = NBATCH * 64 * 2, nall = nlat + (layer == 0 ? NBATCH * 4 * 2 : 0);
    for (int u = F.bid; u < nall; u += F.G) {
        if (u < nlat) { const int kvh = u & 1, qb = (u >> 1) & 63, b = u >> 7; attn_unit(F, layer, b, qb, kvh, false); }
        else { const int v = u - nlat, kvh = v & 1, qb = (v >> 1) & 3, b = v >> 3; attn_unit(F, layer, b, qb, kvh, true); }
    }
    __syncthreads();
}

__device__ __forceinline__ int mlstm_row0(int b, int dir, int j) {
    if (j < 4) { const int cb = dir ? 3 - j : j; return NLAT + b * CTXL + 64 * cb; }
    const int lb = dir ? 67 - j : j - 4; return b * SEQ + 64 * lb;
}
__device__ __forceinline__ float log_sigmoid(float x) { return fminf(x, 0.f) - log1pf(__expf(-fabsf(x))); }
__device__ __forceinline__ float scan_sum(float v, int lane, int dir) {
#pragma unroll
    for (int o = 1; o < 64; o <<= 1) { const float t = dir ? __shfl_down(v, o) : __shfl_up(v, o); const bool ok = dir ? (lane + o < 64) : (lane >= o); v += ok ? t : 0.f; }
    return v;
}
__device__ __forceinline__ float scan_max(float v, int lane, int dir) {
#pragma unroll
    for (int o = 1; o < 64; o <<= 1) { const float t = dir ? __shfl_down(v, o) : __shfl_up(v, o); const bool ok = dir ? (lane + o < 64) : (lane >= o); v = ok ? fmaxf(v, t) : v; }
    return v;
}
constexpr int TP = 72;
__device__ __forceinline__ void mlstm_c1_phase(Frame& F, int layer) {
    const bf16* Z = (const bf16*)(F.ws + WS_Z); const float* GT = (const float*)(F.ws + WS_GATES);
    float* CST = (float*)(F.ws + WS_CST); float* NST = (float*)(F.ws + WS_NST); float* MG = (float*)(F.ws + WS_MG);
    LAS bf16* KT = (LAS bf16*)(F.lds + F.wave * (2 * 64 * TP * 2)); LAS bf16* VT = KT + 64 * TP;
    const int lane = F.lane, l31 = lane & 31, hh = lane >> 5;
    const float* gb = F.in[I_GATEB] + layer * 16;
    for (int u = F.bid * NWAVES + F.wave; u < NSCAN * NCHUNK; u += F.G * NWAVES) {
        const int sc = u / NCHUNK, j = u % NCHUNK, b = sc >> 3, h = (sc >> 1) & 3, dir = sc & 1;
        const int row0 = mlstm_row0(b, dir, j);
        const float li = GT[(size_t)(row0 + lane) * 16 + 8 * dir + h] + gb[8 * dir + h];
        const float lf = log_sigmoid(GT[(size_t)(row0 + lane) * 16 + 8 * dir + 4 + h] + gb[8 * dir + 4 + h]);
        const float bc = scan_sum(lf, lane, dir), g = wave_sum(lf);
        const float wl = g - bc + li, ml = wave_max(wl), ew = __expf(wl - ml) * 0.125f;
#pragma unroll
        for (int i = 0; i < 8; ++i) { const int t = 8 * i + (lane >> 3), c = lane & 7; const float et = __shfl(ew, t);
            float kv[8]; unpack8(*(const v4u*)(Z + (size_t)(row0 + t) * ZC + Z_MK + h * 64 + 8 * c), kv);
            const v4u vv = *(const v4u*)(Z + (size_t)(row0 + t) * ZC + Z_MV + h * 64 + 8 * c);
            v4u kk; kk.x = pk2(kv[0] * et, kv[1] * et); kk.y = pk2(kv[2] * et, kv[3] * et); kk.z = pk2(kv[4] * et, kv[5] * et); kk.w = pk2(kv[6] * et, kv[7] * et);
            *(LAS v4u*)(KT + t * TP + 8 * c) = kk; *(LAS v4u*)(VT + t * TP + 8 * c) = vv; }
        LDS_WAIT();
        const int trb = (8 * hh + ((lane & 15) >> 2)) * TP + 16 * ((lane >> 4) & 1) + 4 * (lane & 3);
        {
            f32x16 cacc[2][2];
#pragma unroll
            for (int a = 0; a < 2; ++a)
#pragma unroll
                for (int c = 0; c < 2; ++c)
#pragma unroll
                    for (int i = 0; i < 16; ++i) cacc[a][c][i] = 0.f;
#pragma unroll
            for (int ks = 0; ks < 4; ++ks) {
                bf16x8 af[2], bfr[2];
#pragma unroll
                for (int x = 0; x < 2; ++x) { const LAS bf16* pv = VT + trb + 16 * ks * TP + 32 * x; const LAS bf16* pk = KT + trb + 16 * ks * TP + 32 * x;
                    af[x] = tr_frag(pv, pv + 4 * TP); bfr[x] = tr_frag(pk, pk + 4 * TP); }
#pragma unroll
                for (int et = 0; et < 2; ++et)
#pragma unroll
                    for (int dt = 0; dt < 2; ++dt) cacc[et][dt] = MFMA32(af[et], bfr[dt], cacc[et][dt]);
            }
            float* cp = CST + (size_t)u * 4096;
#pragma unroll
            for (int et = 0; et < 2; ++et)
#pragma unroll
                for (int dt = 0; dt < 2; ++dt)
#pragma unroll
                    for (int i = 0; i < 16; ++i) cp[(32 * et + (i & 3) + 8 * (i >> 2) + 4 * hh) * 64 + 32 * dt + l31] = cacc[et][dt][i];
        }
        __builtin_amdgcn_sched_barrier(0);
        {
            const bf16x8 ones = (bf16x8){0x3f80, 0x3f80, 0x3f80, 0x3f80, 0x3f80, 0x3f80, 0x3f80, 0x3f80};
            f32x16 nacc[2];
#pragma unroll
            for (int a = 0; a < 2; ++a)
#pragma unroll
                for (int i = 0; i < 16; ++i) nacc[a][i] = 0.f;
#pragma unroll
            for (int ks = 0; ks < 4; ++ks)
#pragma unroll
                for (int dt = 0; dt < 2; ++dt) { const LAS bf16* pk = KT + trb + 16 * ks * TP + 32 * dt; nacc[dt] = MFMA32(ones, tr_frag(pk, pk + 4 * TP), nacc[dt]); }
            if (hh == 0) { NST[(size_t)u * 64 + l31] = nacc[0][0]; NST[(size_t)u * 64 + 32 + l31] = nacc[1][0]; }
        }
        if (lane == 0) { MG[u] = g; MG[NSCAN * NCHUNK + u] = ml; }
        LDS_WAIT();
    }
}
__device__ __forceinline__ void mlstm_c2_phase(Frame& F) {
    float* CST = (float*)(F.ws + WS_CST); float* NST = (float*)(F.ws + WS_NST); float* MG = (float*)(F.ws + WS_MG);
    constexpr int NBT = 17;
    for (int u = F.bid; u < NSCAN * 4; u += F.G) {
        const int sc = u >> 2, qtr = u & 3; const bool nown = (qtr == 0 && F.tid < 64);
        const float* cp = CST + (size_t)sc * NCHUNK * 4096 + qtr * 1024 + F.tid; bf16* cb = (bf16*)(F.ws + WS_CSTB) + (size_t)sc * NCHUNK * 4096 + qtr * 1024 + F.tid; float* np = NST + (size_t)sc * NCHUNK * 64 + (F.tid & 63);
        float c0 = 0.f, c1 = 0.f, n0 = 0.f, mst = 0.f;
#pragma unroll 1
        for (int jb = 0; jb < NCHUNK; jb += NBT) {
            float x0[NBT], x1[NBT], xn[NBT], gj[NBT], mj[NBT];
#pragma unroll
            for (int i = 0; i < NBT; ++i) { x0[i] = cp[(size_t)(jb + i) * 4096]; x1[i] = cp[(size_t)(jb + i) * 4096 + 512]; xn[i] = nown ? np[(jb + i) * 64] : 0.f;
                gj[i] = MG[sc * NCHUNK + jb + i]; mj[i] = MG[NSCAN * NCHUNK + sc * NCHUNK + jb + i]; }
#pragma unroll
            for (int i = 0; i < NBT; ++i) {
                const float mnew = fmaxf(gj[i] + mst, mj[i]), a = __expf(gj[i] + mst - mnew), bb = __expf(mj[i] - mnew);
                { const unsigned pk = pk2(c0, c1); cb[(size_t)(jb + i) * 4096] = (bf16)(pk & 0xffffu); cb[(size_t)(jb + i) * 4096 + 512] = (bf16)(pk >> 16); } c0 = a * c0 + bb * x0[i]; c1 = a * c1 + bb * x1[i];
                if (nown) { np[(jb + i) * 64] = n0; n0 = a * n0 + bb * xn[i]; }
                if (qtr == 0 && F.tid == 0) MG[2 * NSCAN * NCHUNK + sc * NCHUNK + jb + i] = mst;
                mst = mnew;
            }
        }
    }
}
__device__ __forceinline__ void mlstm_c3_phase(Frame& F, int layer) {
    const bf16* Z = (const bf16*)(F.ws + WS_Z); const float* GT = (const float*)(F.ws + WS_GATES);
    const float* CST = (const float*)(F.ws + WS_CST); const float* NST = (const float*)(F.ws + WS_NST); const float* MG = (const float*)(F.ws + WS_MG);
    bf16* YC = (bf16*)(F.ws + WS_YC);
    constexpr int VP3 = 96;
    LAS bf16* VT = (LAS bf16*)(F.lds + F.wave * 16384); LAS float* US = (LAS float*)(F.lds + F.wave * 16384 + 64 * VP3 * 2);
    const int lane = F.lane, l31 = lane & 31, hh = lane >> 5;
    const float* gb = F.in[I_GATEB] + layer * 16; const float* nw = F.in[I_NORMW] + layer * 256;
    const int nlat = NBATCH * 4 * 64, nun = nlat + ((layer == 0) ? 2 * NBATCH * 4 * 4 : 0);
    const int nwv = F.G * NWAVES, npass1 = (nlat + nwv - 1) / nwv, npass2 = (nun - nlat + nwv - 1) / nwv;
    for (int it = 0; it < npass1 + npass2; ++it) {
        const int u = (it < npass1) ? it * nwv + F.bid * NWAVES + F.wave : nlat + (it - npass1) * nwv + F.wave * F.G + F.bid;
        if (u >= ((it < npass1) ? nlat : nun)) continue;
        int tb, bh, st_lo = 0, st_hi = 2;
        if (u < nlat) { tb = 4 + (u & 63); bh = u >> 6; } else { const int v = u - nlat; st_lo = v & 1; st_hi = st_lo + 1; tb = (v >> 1) & 3; bh = v >> 3; }
        const int b = bh >> 2, h = bh & 3;
        const int row0 = tb < 4 ? NLAT + b * CTXL + 64 * tb : b * SEQ + 64 * (tb - 4);
        float mm[2], einter[2], floorv[2]; int cidx[2];
#pragma unroll
        for (int dir = 0; dir < 2; ++dir) {
            const int j = dir ? (tb < 4 ? 3 - tb : 71 - tb) : tb, sc = (b * 4 + h) * 2 + dir; cidx[dir] = sc * NCHUNK + j;
            const float li = GT[(size_t)(row0 + lane) * 16 + 8 * dir + h] + gb[8 * dir + h];
            const float lf = log_sigmoid(GT[(size_t)(row0 + lane) * 16 + 8 * dir + 4 + h] + gb[8 * dir + 4 + h]);
            const float bc = scan_sum(lf, lane, dir), uu = li - bc, pm = scan_max(uu, lane, dir), mprev = MG[2 * NSCAN * NCHUNK + cidx[dir]];
            mm[dir] = fmaxf(mprev, pm); einter[dir] = __expf(mprev - mm[dir]); floorv[dir] = __expf(-bc - mm[dir]);
            US[dir * 64 + lane] = uu;
        }
#pragma unroll
        for (int i = 0; i < 8; ++i) { const int t = 8 * i + (lane >> 3), c = lane & 7;
            *(LAS v4u*)(VT + t * VP3 + 8 * c) = *(const v4u*)(Z + (size_t)(row0 + t) * ZC + Z_MV + h * 64 + 8 * c); }
        LDS_WAIT();
        const LAS bf16* vtr0 = VT + (4 * hh + ((lane & 15) >> 2)) * VP3 + 16 * ((lane >> 4) & 1) + 4 * (lane & 3);
#pragma unroll 1
        for (int st = st_lo; st < st_hi; ++st) {
            const int s = 32 * st + l31;
            bf16x8 qf[4];
#pragma unroll
            for (int ks = 0; ks < 4; ++ks) qf[ks] = *(const bf16x8*)(Z + (size_t)(row0 + s) * ZC + Z_MQ + h * 64 + 16 * ks + 8 * hh);
            f32x16 hm[2];
#pragma unroll
            for (int et = 0; et < 2; ++et)
#pragma unroll
                for (int i = 0; i < 16; ++i) hm[et][i] = 0.f;
#pragma unroll 1
            for (int dir = 0; dir < 2; ++dir) {
                const float mms = __shfl(dir ? mm[1] : mm[0], s), eis = __shfl(dir ? einter[1] : einter[0], s), fls = __shfl(dir ? floorv[1] : floorv[0], s);
                const int ci = dir ? cidx[1] : cidx[0]; const int sm4 = s - 4 * hh;
                f32x16 na[2]; float dsum = 0.f;
#pragma unroll
                for (int et = 0; et < 2; ++et)
#pragma unroll
                    for (int i = 0; i < 16; ++i) na[et][i] = 0.f;
#pragma unroll
                for (int rt = 0; rt < 2; ++rt) {
                    f32x16 sT;
#pragma unroll
                    for (int i = 0; i < 16; ++i) sT[i] = 0.f;
#pragma unroll
                    for (int ks = 0; ks < 4; ++ks) { const bf16x8 kf = *(const bf16x8*)(Z + (size_t)(row0 + 32 * rt + l31) * ZC + Z_MK + h * 64 + 16 * ks + 8 * hh); sT = MFMA32(kf, qf[ks], sT); }
#pragma unroll
                    for (int g = 0; g < 4; ++g) { const f32x4 u4 = *(const LAS f32x4*)(US + dir * 64 + 32 * rt + 8 * g + 4 * hh);
#pragma unroll
                        for (int x = 0; x < 4; ++x) { const int rc = 32 * rt + 8 * g + x; const bool ok = dir ? (rc >= sm4) : (rc <= sm4);
                            const float wv = ok ? __expf(u4[x] - mms) : 0.f; const float v = sT[4 * g + x] * 0.125f * wv; sT[4 * g + x] = v; dsum += v; } }
#pragma unroll
                    for (int sp = 0; sp < 2; ++sp) { v4u pk; pk.x = pk2(sT[8 * sp], sT[8 * sp + 1]); pk.y = pk2(sT[8 * sp + 2], sT[8 * sp + 3]); pk.z = pk2(sT[8 * sp + 4], sT[8 * sp + 5]); pk.w = pk2(sT[8 * sp + 6], sT[8 * sp + 7]);
                        const bf16x8 pf = __builtin_bit_cast(bf16x8, pk);
#pragma unroll
                        for (int et = 0; et < 2; ++et) { const LAS bf16* vp = vtr0 + (32 * rt + 16 * sp) * VP3 + 32 * et;
                            na[et] = MFMA32(tr_frag(vp, vp + 8 * VP3), pf, na[et]); } }
                }
                dsum += __shfl_xor(dsum, 32);
                float qn = 0.f; const float* np = NST + (size_t)ci * 64;
#pragma unroll
                for (int ks = 0; ks < 4; ++ks) { float qv[8]; unpack8(__builtin_bit_cast(v4u, qf[ks]), qv); const f32x4 n0 = *(const f32x4*)(np + 16 * ks + 8 * hh), n1 = *(const f32x4*)(np + 16 * ks + 8 * hh + 4);
                    qn += qv[0] * n0.x + qv[1] * n0.y + qv[2] * n0.z + qv[3] * n0.w + qv[4] * n1.x + qv[5] * n1.y + qv[6] * n1.z + qv[7] * n1.w; }
                qn += __shfl_xor(qn, 32);
                const float den = dsum + eis * qn, inv = 1.0f / fmaxf(fabsf(den), fls);
                const bf16* cp = (const bf16*)(F.ws + WS_CSTB) + (size_t)ci * 4096;
#pragma unroll
                for (int et = 0; et < 2; ++et) {
                    f32x16 nb;
#pragma unroll
                    for (int i = 0; i < 16; ++i) nb[i] = 0.f;
#pragma unroll
                    for (int ks = 0; ks < 4; ++ks) nb = MFMA32(*(const bf16x8*)(cp + (32 * et + l31) * 64 + 16 * ks + 8 * hh), qf[ks], nb);
#pragma unroll
                    for (int i = 0; i < 16; ++i) hm[et][i] += (na[et][i] + eis * nb[i]) * inv;
                }
            }
            float sum = 0.f;
#pragma unroll
            for (int et = 0; et < 2; ++et)
#pragma unroll
                for (int i = 0; i < 16; ++i) sum += hm[et][i];
            sum += __shfl_xor(sum, 32); const float mu = sum * (1.f / 64.f); float q = 0.f;
#pragma unroll
            for (int et = 0; et < 2; ++et)
#pragma unroll
                for (int i = 0; i < 16; ++i) { const float d = hm[et][i] - mu; q += d * d; }
            q += __shfl_xor(q, 32); const float rstd = 1.0f / sqrtf(q * (1.f / 64.f) + LN_EPS);
            const bf16* og = Z + (size_t)(row0 + s) * ZC + Z_MO + h * 64; bf16* yp = YC + (size_t)(row0 + s) * 256 + h * 64;
#pragma unroll
            for (int et = 0; et < 2; ++et)
#pragma unroll
                for (int g = 0; g < 4; ++g) { const int e0 = 32 * et + 8 * g + 4 * hh; const v2u ov = *(const v2u*)(og + e0); const f32x4 wv = *(const f32x4*)(nw + h * 64 + e0);
                    const float y0 = (hm[et][4 * g] - mu) * rstd * wv.x * fsig(bflo(ov.x)), y1 = (hm[et][4 * g + 1] - mu) * rstd * wv.y * fsig(bfhi(ov.x));
                    const float y2 = (hm[et][4 * g + 2] - mu) * rstd * wv.z * fsig(bflo(ov.y)), y3 = (hm[et][4 * g + 3] - mu) * rstd * wv.w * fsig(bfhi(ov.y));
                    v2u o; o.x = pk2(y0, y1); o.y = pk2(y2, y3); *(v2u*)(yp + e0) = o; }
        }
        LDS_WAIT();
    }
}

__device__ __forceinline__ void moe_tables(Frame& F, int layer) {
    LAS int* tot = (LAS int*)(F.lds + LDS_TOT);
    if (F.tid < 32) tot[F.tid] = __hip_atomic_load((int*)(F.ws + WS_CTL) + CW_CNTG + layer * 32 + F.tid, RLX_AGENT);
    __syncthreads();
}
__device__ __forceinline__ int moe_tile_table(Frame& F) {
    LAS int* tot = (LAS int*)(F.lds + LDS_TOT); LAS int* te = (LAS int*)(F.lds + LDS_TILE_E); LAS int* first = (LAS int*)(F.lds + LDS_BELOW);
    int nt = 0;
    for (int e = 0; e < NEXP; ++e) { const int n = (tot[e] + 255) >> 8; for (int i = F.tid; i < n; i += NTHREADS) te[nt + i] = e; if (F.tid == 0) first[e] = nt; nt += n; }
    __syncthreads();
    return nt;
}

#define XB_TMO      128
#define XB_XCNT(j)  (256  + 64 * (j))
#define XB_XSUB(j)  (1280 + 64 * (j))
#define XB_XGEN(j)  (2304 + 64 * (j))
#define XB_TOP      3328
#define XB_TOPGEN   3392
#define XCD_BAR_WORDS 3456
#define XB_SPIN_CAP (1u << 18)

__device__ __forceinline__ unsigned xb_ld(unsigned* p)              { return __hip_atomic_load(p, __ATOMIC_RELAXED, __HIP_MEMORY_SCOPE_AGENT); }
__device__ __forceinline__ unsigned xb_add(unsigned* p, unsigned v) { return __hip_atomic_fetch_add(p, v, __ATOMIC_RELAXED, __HIP_MEMORY_SCOPE_AGENT); }
__device__ __forceinline__ unsigned xb_xcc_id() { return (unsigned)__builtin_amdgcn_s_getreg((3 << 11) | 20) & 0xFu; }
#define XB_SPIN(cond, bar) do { unsigned _sp = 0; while (cond) { __builtin_amdgcn_s_sleep(1); \
    if ((++_sp & 255u) == 0u) { if (xb_ld(&(bar)[XB_TMO])) break; if (_sp > XB_SPIN_CAP) { atomicAdd(&(bar)[XB_TMO], 1u); break; } } } } while (0)

struct XcdBarrier {
    unsigned* bar; unsigned x;
    volatile LAS unsigned* st;
};

__device__ __forceinline__ XcdBarrier xcd_barrier_post(unsigned* bar, volatile LAS unsigned* st) {
    XcdBarrier b; b.bar = bar; b.x = xb_xcc_id(); b.st = st;
    if (threadIdx.x == 0) (void)xb_add(&bar[XB_XCNT(b.x)], 1u);
    return b;
}
__device__ __forceinline__ void xcd_barrier_complete(unsigned* bar, unsigned x, unsigned& nloc, unsigned& nx) {
    const unsigned G = gridDim.x * gridDim.y * gridDim.z;
    unsigned sum, cnt, mine, sp = 0u;
    for (;;) {
        sum = 0u; cnt = 0u; mine = 0u;
#pragma unroll
        for (unsigned j = 0; j < 16; ++j) { const unsigned c = xb_ld(&bar[XB_XCNT(j)]); sum += c; cnt += (c > 0u) ? 1u : 0u; mine = (j == x) ? c : mine; }
        if (sum == G) break;
        __builtin_amdgcn_s_sleep(1);
        if ((++sp & 255u) == 0u) { if (xb_ld(&bar[XB_TMO])) break; if (sp > XB_SPIN_CAP) { atomicAdd(&bar[XB_TMO], 1u); break; } }
    }
    nloc = mine > 0u ? mine : 1u; nx = cnt > 0u ? cnt : 1u;
}

__device__ __forceinline__ void xcd_barrier(const XcdBarrier& b) {
    asm volatile("s_waitcnt vmcnt(0)" ::: "memory");
    __syncthreads();
    if (threadIdx.x == 0) {
        unsigned* bar = b.bar;
        __builtin_amdgcn_s_waitcnt(0);
        unsigned nloc = b.st[0], nx = b.st[1];
        if (nloc == 0u) { xcd_barrier_complete(bar, b.x, nloc, nx); b.st[0] = nloc; b.st[1] = nx; }
        const unsigned old = xb_add(&bar[XB_XSUB(b.x)], 1u);
        const unsigned gen = old / nloc;
        if (old + 1u == (gen + 1u) * nloc) {
            __builtin_amdgcn_fence(__ATOMIC_RELEASE, "agent");
            asm volatile("s_waitcnt vmcnt(0)" ::: "memory");
            const unsigned og = xb_add(&bar[XB_TOP], 1u);
            const unsigned tg = og / nx;
            if (og + 1u == (tg + 1u) * nx) xb_add(&bar[XB_TOPGEN], 1u);
            else XB_SPIN(xb_ld(&bar[XB_TOPGEN]) == tg, bar);
            __builtin_amdgcn_fence(__ATOMIC_ACQUIRE, "agent");
            xb_add(&bar[XB_XGEN(b.x)], 1u);
            asm volatile("s_waitcnt vmcnt(0)" ::: "memory");
        } else {
            XB_SPIN(xb_ld(&bar[XB_XGEN(b.x)]) == gen, bar);
            __builtin_amdgcn_fence(__ATOMIC_ACQUIRE, "agent");
            asm volatile("s_waitcnt vmcnt(0)" ::: "memory");
        }
    }
    __syncthreads();
}

#ifndef PHASE_SEL
#define PHASE_SEL 0xFFFF
#endif
#define PH(n) (((PHASE_SEL) >> (n)) & 1)
constexpr int N_PHASES = 2 + 11 * DEPTH;
#ifndef REPEAT_SEL
#define REPEAT_SEL 0
#endif
struct Args { const float* in[25]; float* out; unsigned char* ws; int ph_lo, ph_hi, rep, pad; };
#if MK_ONE_LAUNCH
#define GRID_BAR() xcd_barrier(bar)
#else
#define GRID_BAR() do { } while (0)
#endif
#define FENCE_PHASE() do { int z_, l_; asm volatile("s_mov_b32 %0, 0" : "=s"(z_)); asm volatile("v_mbcnt_lo_u32_b32 %0, -1, 0\n\tv_mbcnt_hi_u32_b32 %0, -1, %0" : "=v"(l_)); \
        z_ = __builtin_amdgcn_readfirstlane(z_); F.ws = args.ws + z_; F.wave = wave0 + z_; F.lane = l_; F.tid = F.wave * 64 + l_; F.lds = lds + z_; } while (0)
#define IN(k) (lo <= (k) && (k) < hi)
#ifndef REPEAT_N
#define REPEAT_N 1
#endif
#if ((REPEAT_SEL) >> 0) & 1
#define REP0 _Pragma("unroll") for (int rep_ = 0; rep_ < 1 + REPEAT_N; ++rep_)
#else
#define REP0
#endif
#if ((REPEAT_SEL) >> 1) & 1
#define REP1 _Pragma("unroll") for (int rep_ = 0; rep_ < 1 + REPEAT_N; ++rep_)
#else
#define REP1
#endif
#if ((REPEAT_SEL) >> 2) & 1
#define REP2 _Pragma("unroll") for (int rep_ = 0; rep_ < 1 + REPEAT_N; ++rep_)
#else
#define REP2
#endif
#if ((REPEAT_SEL) >> 3) & 1
#define REP3 _Pragma("unroll") for (int rep_ = 0; rep_ < 1 + REPEAT_N; ++rep_)
#else
#define REP3
#endif
#if ((REPEAT_SEL) >> 4) & 1
#define REP4 _Pragma("unroll") for (int rep_ = 0; rep_ < 1 + REPEAT_N; ++rep_)
#else
#define REP4
#endif
#if ((REPEAT_SEL) >> 5) & 1
#define REP5 _Pragma("unroll") for (int rep_ = 0; rep_ < 1 + REPEAT_N; ++rep_)
#else
#define REP5
#endif
#if ((REPEAT_SEL) >> 6) & 1
#define REP6 _Pragma("unroll") for (int rep_ = 0; rep_ < 1 + REPEAT_N; ++rep_)
#else
#define REP6
#endif
#if ((REPEAT_SEL) >> 7) & 1
#define REP7 _Pragma("unroll") for (int rep_ = 0; rep_ < 1 + REPEAT_N; ++rep_)
#else
#define REP7
#endif
#if ((REPEAT_SEL) >> 8) & 1
#define REP8 _Pragma("unroll") for (int rep_ = 0; rep_ < 1 + (layer == 0 ? REPEAT_N : 0); ++rep_)
#else
#define REP8
#endif
#if ((REPEAT_SEL) >> 9) & 1
#define REP9 _Pragma("unroll") for (int rep_ = 0; rep_ < 1 + REPEAT_N; ++rep_)
#else
#define REP9
#endif
#if ((REPEAT_SEL) >> 10) & 1
#define REP10 _Pragma("unroll") for (int rep_ = 0; rep_ < 1 + REPEAT_N; ++rep_)
#else
#define REP10
#endif
#if ((REPEAT_SEL) >> 11) & 1
#define REP11 _Pragma("unroll") for (int rep_ = 0; rep_ < 1 + REPEAT_N; ++rep_)
#else
#define REP11
#endif
#if ((REPEAT_SEL) >> 12) & 1
#define REP12 _Pragma("unroll") for (int rep_ = 0; rep_ < 1 + REPEAT_N; ++rep_)
#else
#define REP12
#endif
#define SEAM(k) do { if (IN(k) && IN((k) + 1)) GRID_BAR(); } while (0)
template <int layer> __device__ __forceinline__ void run_layer(Frame& F, const Args& args, LAS unsigned char* lds, const XcdBarrier& bar, const int lo, const int hi, const int wave0) {
        const int pb = 2 + 11 * layer;
        const int Ml = (layer == 0) ? MTOT : NLAT;
        REP2 { if (PH(2) && IN(pb + 0)) { FENCE_PHASE();
#if defined(PROBE_NULLEPI) && (((REPEAT_SEL) >> 2) & 1)
            if (rep_ > 0) {
            { pg8::Gemm g{(const bf16*)(F.ws + WS_H), (const bf16*)(F.ws + WS_W + (size_t)layer * W_LAYER + W_IN), MTOT, ZC, D};
              pg8::InprojOrder S; S.base.init(Ml, ZC, F.G, F.bid); S.nextra = (Ml == MTOT) ? 0 : 3 * (NCTX / 256); S.pm0 = NLAT / 256;
              pg8::EpiBf16<0> E{(bf16*)(F.ws + WS_Z), ZC, nullptr, 0, 0, 1.f}; pg8::EpiNull E0;
              if (PROBE_NULLEPI & 16) { g.KT = 32; S.base.init(Ml / 2, ZC, F.G, F.bid); S.nextra = 0; }
              if (PROBE_NULLEPI & 32) { g.KT = 8; S.base.init(Ml * 2 > MTOT ? MTOT : Ml * 2, ZC, F.G, F.bid); S.nextra = 0; }
              if (PROBE_NULLEPI & 1) pg8::gemm_phase<pg8::EpiNull, pg8::InprojOrder, true, true>(F.lds, g, S, E0, F.tid); else if (!(PROBE_NULLEPI & 4)) pg8::gemm_phase<pg8::EpiBf16<0>, pg8::InprojOrder, true, true>(F.lds, g, S, E, F.tid); }
            { pg8::Gemm g{(const bf16*)(F.ws + WS_H8), (const bf16*)(F.ws + WS_W + (size_t)layer * W_LAYER + W_G8), MTOT, NGC, D / 2};
              pg8::StaticOrder S; S.init(Ml, NGC, F.G, F.G - 1 - F.bid);
              pg8::EpiG8 E{(unsigned char*)(F.ws + WS_GU8), NGC, WQ_INV}; pg8::EpiNull E0;
              if (PROBE_NULLEPI & 2) pg8::gemm_phase<pg8::EpiNull, pg8::StaticOrder, true, true, true>(F.lds, g, S, E0, F.tid); else if (!(PROBE_NULLEPI & 8)) pg8::gemm_phase<pg8::EpiG8, pg8::StaticOrder, true, true, true>(F.lds, g, S, E, F.tid); }
            } else
#endif
            {
            { pg8::Gemm g{(const bf16*)(F.ws + WS_H), (const bf16*)(F.ws + WS_W + (size_t)layer * W_LAYER + W_IN), MTOT, ZC, D};
              pg8::InprojOrder S; S.base.init(Ml, ZC, F.G, F.bid); S.nextra = (Ml == MTOT) ? 0 : 3 * (NCTX / 256); S.pm0 = NLAT / 256;
              pg8::EpiBf16<0> E{(bf16*)(F.ws + WS_Z), ZC, nullptr, 0, 0, 1.f};
              pg8::gemm_phase<pg8::EpiBf16<0>, pg8::InprojOrder, true, true>(F.lds, g, S, E, F.tid); }
            { pg8::Gemm g{(const bf16*)(F.ws + WS_H8), (const bf16*)(F.ws + WS_W + (size_t)layer * W_LAYER + W_G8), MTOT, NGC, D / 2};
              pg8::StaticOrder S; S.init(Ml, NGC, F.G, F.G - 1 - F.bid);
              pg8::EpiG8 E{(unsigned char*)(F.ws + WS_GU8), NGC, WQ_INV};
              pg8::gemm_phase<pg8::EpiG8, pg8::StaticOrder, true, true, true>(F.lds, g, S, E, F.tid); }
            }
        } SEAM(pb + 0); }
        REP3 { if (PH(3) && IN(pb + 1)) { FENCE_PHASE();
#ifndef SUB_SEL
#define SUB_SEL 7
#endif
            for (int ra = 0; ra < 1 + (((REPEAT_SEL) >> 13) & 1); ++ra) attn_phase(F, layer);
            for (int rb = 0; rb < 1 + (((REPEAT_SEL) >> 14) & 1); ++rb) { __syncthreads(); mlstm_c1_phase(F, layer); }
            conv_phase(F, layer, Ml); } SEAM(pb + 1); }
        REP4 { if (PH(4) && IN(pb + 2)) { FENCE_PHASE(); mlstm_c2_phase(F); } SEAM(pb + 2); }
        REP5 { if (PH(5) && IN(pb + 3)) { FENCE_PHASE(); mlstm_c3_phase(F, layer); } SEAM(pb + 3); }
        REP6 { if (PH(6) && IN(pb + 4)) { FENCE_PHASE();
            pg8::Gemm g{(const bf16*)(F.ws + WS_YA), (const bf16*)(F.ws + WS_W + (size_t)layer * W_LAYER + W_PA), 4 * MTOT, D, 256};
            pg8::MergeOrder S{(Ml / 256) * 4, MTOT / 256, F.G, F.bid};
            pg8::EpiMerge E{(const unsigned char*)(F.ws + WS_GU8), NGC, (bf16*)(F.ws + WS_MERGED), D, MTOT / 256, (unsigned char*)(F.ws + WS_MERGED8)};
            pg8::gemm_phase<pg8::EpiMerge, pg8::MergeOrder, true, true>(F.lds, g, S, E, F.tid);
        } SEAM(pb + 4); }
        REP7 { if (PH(7) && IN(pb + 5)) { FENCE_PHASE();
            pg8::Gemm g{(const bf16*)(F.ws + WS_MERGED8), (const bf16*)(F.ws + WS_W + (size_t)layer * W_LAYER + W_O8), Ml, D, D / 2}; pg8::StaticOrder S; S.init(Ml, D, F.G, F.bid);
            pg8::EpiBf16S E{(bf16*)(F.ws + WS_YL), D, WQ_INV};
            pg8::gemm_phase<pg8::EpiBf16S, pg8::StaticOrder, true, true, true>(F.lds, g, S, E, F.tid);
        } SEAM(pb + 5); }
        REP8 { if (PH(8) && IN(pb + 6)) { FENCE_PHASE(); __syncthreads(); ln1_phase(F, layer, Ml); } SEAM(pb + 6); }
        REP10 { if (PH(10) && IN(pb + 8)) { FENCE_PHASE();
            moe_tables(F, layer); const int nt = moe_tile_table(F);
            { LAS int* tt = (LAS int*)(F.lds + LDS_TOKTAB); const int* TOKE = (const int*)(F.ws + WS_TOKE);
              const LAS int* te = (const LAS int*)(F.lds + LDS_TILE_E); const LAS int* first = (const LAS int*)(F.lds + LDS_BELOW); const LAS int* tot = (const LAS int*)(F.lds + LDS_TOT);
              for (int i = 0; i < 6; ++i) { int t, pn; pg8::MoeOrder::unit_of(i, F.G, F.bid, t, pn); if (t >= nt) break;
                  if (F.tid < 256) { const int e = te[t], p = (t - first[e]) * 256 + F.tid; tt[i * 256 + F.tid] = (p < tot[e]) ? TOKE[(size_t)e * MTOT + p] : 0; } }
              __syncthreads(); }
            pg8::Gemm g{(const bf16*)(F.ws + WS_H8), (const bf16*)(F.ws + WS_W + (size_t)layer * W_LAYER + W_EI), PMAX, D, D / 2};
            pg8::MoeGatherOrder S; S.tile_e = (const LAS int*)(F.lds + LDS_TILE_E); S.ntiles = nt; S.G = F.G; S.c = F.bid; S.tok = (const LAS int*)(F.lds + LDS_TOKTAB);
            pg8::EpiSwiGLU8 E{(unsigned char*)(F.ws + WS_ACT), DEXP, WQ_INV};
            pg8::gemm_phase<pg8::EpiSwiGLU8, pg8::MoeGatherOrder, true, true, true>(F.lds, g, S, E, F.tid);
        } SEAM(pb + 8); }
        REP11 { if (PH(11) && IN(pb + 9)) { FENCE_PHASE();
            moe_tables(F, layer); const int nt = moe_tile_table(F);
            pg8::Gemm g{(const bf16*)(F.ws + WS_ACT), (const bf16*)(F.ws + WS_W + (size_t)layer * W_LAYER + W_EO), PMAX, D, DEXP / 2};     pg8::MoeOrder S{(const LAS int*)(F.lds + LDS_TILE_E), nt, F.G, F.bid};
            pg8::EpiF8S E{(unsigned char*)(F.ws + WS_XG), D, 16.0f * WQ_INV};
            pg8::gemm_phase<pg8::EpiF8S, pg8::MoeOrder, true, true, true>(F.lds, g, S, E, F.tid);
        } SEAM(pb + 9); }
        REP12 { if (PH(12) && IN(pb + 10)) { FENCE_PHASE(); ln2_phase(F, layer, Ml); } SEAM(pb + 10); }
    }
__global__ void __launch_bounds__(NTHREADS, 2) hybrid_fwd(Args args) {
    extern __shared__ __attribute__((aligned(16))) unsigned char lds_raw[];
    LAS unsigned char* lds = (LAS unsigned char*)lds_raw;
    Frame F;
    F.lds = lds;
    F.tid = threadIdx.x; F.lane = F.tid & 63; F.wave = __builtin_amdgcn_readfirstlane(F.tid >> 6); F.G = gridDim.x; F.bid = blockIdx.x;
    const int wave0 = F.wave;
    F.in = args.in;
    F.out = args.out; F.ws = args.ws;
    volatile LAS unsigned* MISC = (volatile LAS unsigned*)(F.lds + LDS_MISC);
    if (F.tid < 32) MISC[F.tid] = 0u;
    __syncthreads();
    XcdBarrier bar; bar.bar = nullptr; bar.x = 0; bar.st = nullptr;
#if MK_ONE_LAUNCH
    bar = xcd_barrier_post((unsigned*)(F.ws + WS_CTL) + CW_BAR, MISC + 8);
#endif
    const int lo = args.ph_lo, hi = args.ph_hi;
    #ifndef P0_MODE
#define P0_MODE 0
#endif
    { int rep0_ = 0; REP0 { if (PH(0) && IN(0)) { FENCE_PHASE(); p0_prologue(F, rep0_ ? P0_MODE : 0); } SEAM(0); ++rep0_; } }
    REP1 { if (PH(1) && IN(1)) { FENCE_PHASE(); ln0_phase(F); } SEAM(1); }
#ifdef EXTRA_BARS
    for (int eb = 0; eb < EXTRA_BARS; ++eb) GRID_BAR();
#endif
    run_layer<0>(F, args, lds, bar, lo, hi, wave0);
    run_layer<1>(F, args, lds, bar, lo, hi, wave0);
}
#undef IN
#undef SEAM


extern "C" void kernel_launch(void* const* d_in, const int* in_sizes, int n_in, void* d_out, int out_size, void* d_ws, size_t ws_size, hipStream_t stream) {
    static int grid = 0;
    if (grid == 0) {
        if (n_in != 25 || in_sizes[0] != NLAT * D || out_size != NLAT * D || ws_size < WS_END) { fprintf(stderr, "kernel_launch: unexpected shapes / workspace (n_in %d, ws %zu)\n", n_in, ws_size); grid = -1; return; }
        int dev = 0, cus = 0, per_cu = 0;
        if (hipGetDevice(&dev) != hipSuccess || hipDeviceGetAttribute(&cus, hipDeviceAttributeMultiprocessorCount, dev) != hipSuccess) { grid = -1; return; }
        if (hipFuncSetAttribute((const void*)hybrid_fwd, hipFuncAttributeMaxDynamicSharedMemorySize, LDS_BYTES) != hipSuccess) { fprintf(stderr, "kernel_launch: hipFuncSetAttribute failed\n"); grid = -1; return; }
        if (hipOccupancyMaxActiveBlocksPerMultiprocessor(&per_cu, (const void*)hybrid_fwd, NTHREADS, LDS_BYTES) != hipSuccess || per_cu < 1) { fprintf(stderr, "kernel_launch: occupancy query says %d blocks per CU\n", per_cu); }
        (void)hipGetLastError();
        grid = cus;
    }
    if (grid < 0) return;
    (void)hipMemsetAsync((char*)d_ws + WS_CTL, 0, CTL_ZERO_BYTES, stream);
    Args a{};
    for (int i = 0; i < 25; ++i) a.in[i] = (const float*)d_in[i];
    a.out = (float*)d_out; a.ws = (unsigned char*)d_ws; a.rep = REPEAT_SEL; a.pad = 0;
#if MK_ONE_LAUNCH
    a.ph_lo = 0; a.ph_hi = N_PHASES;
    hipLaunchKernelGGL(hybrid_fwd, dim3(grid), dim3(NTHREADS), LDS_BYTES, stream, a);
#else
    for (int p = 0; p < N_PHASES; ++p) { a.ph_lo = p; a.ph_hi = p + 1; hipLaunchKernelGGL(hybrid_fwd, dim3(grid), dim3(NTHREADS), LDS_BYTES, stream, a); }
#endif
}
```

```cpp
#include <hip/hip_runtime.h>
#include <cstdio>
#include <cstdint>
#ifndef MK_ONE_LAUNCH
#define MK_ONE_LAUNCH 1
#endif

namespace pg8 {
#define PG8_LAS __attribute__((address_space(3)))
typedef unsigned short bf16_t;
typedef short bf16x8 __attribute__((ext_vector_type(8)));
typedef float f32x4 __attribute__((ext_vector_type(4)));
typedef unsigned u32x4 __attribute__((ext_vector_type(4)));
constexpr int BM = 256, BK = 64, HALF = 128, HTB = HALF * BK * 2  , STAGE_BYTES = 8 * HTB, NXCD = 8, WGM = 8;

__host__ __device__ __forceinline__ int lds_byte(int r, int c) { const int st = (r >> 4) * 2 + (c >> 5), rr = r & 15, cc = c & 31, ob = rr * 64 + cc * 2; return st * 1024 + (ob ^ (((ob >> 9) & 1) << 5)); }
__host__ __device__ __forceinline__ void stage_rc(int b, int& R, int& C) { const int st = b / 1024, sb = b % 1024, swz = sb ^ (((sb >> 9) & 1) << 5); R = (st >> 1) * 16 + swz / 64; C = (st & 1) * 32 + (swz % 64) / 2; }
__host__ __device__ __forceinline__ int perm32(int rho) { const int n = rho >> 4, i = rho & 15; return 8 * (i >> 2) + 4 * n + (i & 3); }

struct Unit { int pm, pn, bn, kh; };
struct Gemm { const bf16_t* A; const bf16_t* Bt; int M, N, K, KT; };

struct StaticOrder {
    int nM, nN, nwg, G, c;
    __host__ __device__ void init(int M, int N, int G_, int c_) { nM = M / BM; nN = N / BM; nwg = nM * nN; G = G_; c = c_; }
    __host__ __device__ bool next(int i, Unit& u) const {
        const long L = (long)i * G + c; if (L >= nwg) return false;
        int wgid = (int)L; { const int q = nwg / NXCD, r = nwg % NXCD, xcd = wgid % NXCD, off = wgid / NXCD; wgid = (xcd < r ? xcd * (q + 1) : r * (q + 1) + (xcd - r) * q) + off; }
        const int nig = WGM * nN, gid = wgid / nig, fm = gid * WGM, gsz = (nM - fm) < WGM ? (nM - fm) : WGM;
        u.pm = fm + ((wgid % nig) % gsz); u.pn = (wgid % nig) / gsz; u.bn = u.pn; return true;
    }
    static constexpr bool GATHER = false;
    __device__ __forceinline__ int a_tile(const Unit& u) const { return u.pm; }
    __device__ __forceinline__ size_t k_off(const Unit&) const { return 0; }
    __device__ __forceinline__ bool carry(const Unit&) const { return false; }
    __device__ __forceinline__ void a_ready(const Unit&) const {}
    __device__ __forceinline__ void done(const Unit&) const {}
};

__device__ __forceinline__ unsigned cvt_pk_bf16(float lo, float hi) { unsigned r; asm volatile("v_cvt_pk_bf16_f32 %0, %1, %2" : "=v"(r) : "v"(lo), "v"(hi)); return r; }
typedef float f32x2 __attribute__((ext_vector_type(2)));
__device__ __forceinline__ f32x2 gelu_pk(f32x2 v) {
    const f32x2 av = __builtin_elementwise_abs(v), d = av * 0.2316418882f + 1.0f;
    f32x2 t; t.x = __builtin_amdgcn_rcpf(d.x); t.y = __builtin_amdgcn_rcpf(d.y);
    f32x2 q = t * 0.5307027145f + (-0.7265760135f); q = q * t + 0.7107068705f; q = q * t + (-0.142248368f); q = q * t + 0.127414796f; q = q * t;
    const f32x2 s = (v * v) * (-0.72134752044f);
    f32x2 e; e.x = __builtin_amdgcn_exp2f(s.x); e.y = __builtin_amdgcn_exp2f(s.y);
    const f32x2 m = v * (q * e), r = v - m;
    f32x2 o; o.x = v.x < 0.f ? m.x : r.x; o.y = v.y < 0.f ? m.y : r.y; return o;
}

template <int ACT  > struct EpiBf16 {
    static constexpr bool PERM = true, AFTER_DRAIN = false; static_assert(ACT == 0 || ACT == 1, "EpiBf16: ACT is 0 (none) or 1 (gelu_pk)");
    bf16_t* O; int ldc; const float* bias; int split_cols; size_t split_stride; float scale0;
    __device__ __forceinline__ void operator()(const f32x4 (&acc)[2][2][4][2], const Unit& u, int wr, int wc, int fr, int fq) const {
        const int row0 = u.pm * BM + wr * 64 + fr; int colt = u.pn * BM; bf16_t* base = O;
        float sc = 1.f; if (split_cols) { const int t = colt / split_cols; base += (size_t)t * split_stride; colt -= t * split_cols; if (t == 0) sc = scale0; }
        const int col0 = colt + wc * 32 + 8 * fq, bcol0 = u.pn * BM + wc * 32 + 8 * fq;
        f32x4 bv[2][2];
#pragma unroll
        for (int bj = 0; bj < 2; ++bj)
#pragma unroll
            for (int n = 0; n < 2; ++n) bv[bj][n] = bias ? *(const f32x4*)(bias + bcol0 + bj * HALF + 4 * n) : (f32x4){0.f, 0.f, 0.f, 0.f};
#pragma unroll
        for (int ai = 0; ai < 2; ++ai)
#pragma unroll
            for (int m = 0; m < 4; ++m) { bf16_t* rowp = base + (size_t)(row0 + ai * HALF + m * 16) * ldc + col0;
#pragma unroll
                for (int bj = 0; bj < 2; ++bj) { f32x4 v0 = acc[ai][bj][m][0] + bv[bj][0], v1 = acc[ai][bj][m][1] + bv[bj][1];
                    if (ACT == 1) { f32x2 a = gelu_pk((f32x2){v0[0], v0[1]}), b = gelu_pk((f32x2){v0[2], v0[3]}), c = gelu_pk((f32x2){v1[0], v1[1]}), d = gelu_pk((f32x2){v1[2], v1[3]});
                        v0 = (f32x4){a.x, a.y, b.x, b.y}; v1 = (f32x4){c.x, c.y, d.x, d.y}; }
                    v0 = v0 * sc; v1 = v1 * sc; u32x4 w; w.x = cvt_pk_bf16(v0[0], v0[1]); w.y = cvt_pk_bf16(v0[2], v0[3]); w.z = cvt_pk_bf16(v1[0], v1[1]); w.w = cvt_pk_bf16(v1[2], v1[3]);
                    *(u32x4*)(rowp + bj * HALF) = w; } }
    }
};

__device__ __forceinline__ float fsigmoid(float x) { return __builtin_amdgcn_rcpf(1.0f + __expf(-x)); }
__device__ __forceinline__ float bflo(unsigned w) { return __uint_as_float(w << 16); }
__device__ __forceinline__ float bfhi(unsigned w) { return __uint_as_float(w & 0xffff0000u); }

struct EpiZ {
    static constexpr bool PERM = true, AFTER_DRAIN = false;
    bf16_t* Z; int ldz; unsigned char* G8; int ldg; int nz;
    __device__ __forceinline__ void operator()(const f32x4 (&acc)[2][2][4][2], const Unit& u, int wr, int wc, int fr, int fq) const {
        const int row0 = u.pm * BM + wr * 64 + fr;
        if (u.pn < nz) {
            const int col0 = u.pn * BM + wc * 32 + 8 * fq;
#pragma unroll
            for (int ai = 0; ai < 2; ++ai)
#pragma unroll
                for (int m = 0; m < 4; ++m) { bf16_t* rowp = Z + (size_t)(row0 + ai * HALF + m * 16) * ldz + col0;
#pragma unroll
                    for (int bj = 0; bj < 2; ++bj) { const f32x4 v0 = acc[ai][bj][m][0], v1 = acc[ai][bj][m][1];
                        u32x4 w; w.x = cvt_pk_bf16(v0[0], v0[1]); w.y = cvt_pk_bf16(v0[2], v0[3]); w.z = cvt_pk_bf16(v1[0], v1[1]); w.w = cvt_pk_bf16(v1[2], v1[3]);
                        *(u32x4*)(rowp + bj * HALF) = w; } }
        } else {
            const int col0 = (u.pn - nz) * BM + wc * 32 + 8 * fq;
#pragma unroll
            for (int ai = 0; ai < 2; ++ai)
#pragma unroll
                for (int m = 0; m < 4; ++m) { unsigned char* rowp = G8 + (size_t)(row0 + ai * HALF + m * 16) * ldg + col0;
#pragma unroll
                    for (int bj = 0; bj < 2; ++bj) { const f32x4 v0 = acc[ai][bj][m][0], v1 = acc[ai][bj][m][1]; unsigned lo = 0u, hi = 0u;
                        lo = __builtin_amdgcn_cvt_pk_u8_f32(255.0f * fsigmoid(v0[0]), 0, lo); lo = __builtin_amdgcn_cvt_pk_u8_f32(255.0f * fsigmoid(v0[1]), 1, lo);
                        lo = __builtin_amdgcn_cvt_pk_u8_f32(255.0f * fsigmoid(v0[2]), 2, lo); lo = __builtin_amdgcn_cvt_pk_u8_f32(255.0f * fsigmoid(v0[3]), 3, lo);
                        hi = __builtin_amdgcn_cvt_pk_u8_f32(255.0f * fsigmoid(v1[0]), 0, hi); hi = __builtin_amdgcn_cvt_pk_u8_f32(255.0f * fsigmoid(v1[1]), 1, hi);
                        hi = __builtin_amdgcn_cvt_pk_u8_f32(255.0f * fsigmoid(v1[2]), 2, hi); hi = __builtin_amdgcn_cvt_pk_u8_f32(255.0f * fsigmoid(v1[3]), 3, hi);
                        typedef unsigned u32x2 __attribute__((ext_vector_type(2))); *(u32x2*)(rowp + bj * HALF) = (u32x2){lo, hi}; } }
        }
    }
};
struct EpiNull {
    static constexpr bool PERM = true, AFTER_DRAIN = false;
    __device__ __forceinline__ void operator()(const f32x4 (&acc)[2][2][4][2], const Unit&, int, int, int, int) const {
#pragma unroll
        for (int a = 0; a < 2; ++a)
#pragma unroll
            for (int b = 0; b < 2; ++b)
#pragma unroll
                for (int m = 0; m < 4; ++m)
#pragma unroll
                    for (int n = 0; n < 2; ++n) asm volatile("" :: "v"(acc[a][b][m][n]));
    }
};
#ifndef PROBE_EPIFLAGS
#define PROBE_EPIFLAGS 0
#endif
template <class E> struct epi_probe_flags { static constexpr int v = 0; };
template <> struct epi_probe_flags<EpiNull> { static constexpr int v = PROBE_EPIFLAGS; };
struct EpiMerge {
    static constexpr bool PERM = true, AFTER_DRAIN = false;
    const unsigned char* gate; int ldg; bf16_t* O; int ldo; int nrt; unsigned char* O8;
    __device__ __forceinline__ void operator()(const f32x4 (&acc)[2][2][4][2], const Unit& u, int wr, int wc, int fr, int fq) const {
        typedef unsigned u32x2 __attribute__((ext_vector_type(2)));
        const int br = u.pm / nrt, pm = u.pm - br * nrt, gsel = (br + 1) >> 1;
        const int row0 = pm * BM + wr * 64 + fr, col0 = u.pn * BM + wc * 32 + 8 * fq;
        const unsigned char* gp = gate + (size_t)row0 * ldg + gsel * 1024 + col0; bf16_t* op = O + (size_t)row0 * ldo + col0;
        u32x2 g[2][4][2];
#pragma unroll
        for (int ai = 0; ai < 2; ++ai)
#pragma unroll
            for (int m = 0; m < 4; ++m)
#pragma unroll
                for (int bj = 0; bj < 2; ++bj) g[ai][m][bj] = *(const u32x2*)(gp + (size_t)(ai * HALF + m * 16) * ldg + bj * HALF);
        constexpr float S = 1.0f / 255.0f;
#pragma unroll
        for (int ai = 0; ai < 2; ++ai) {
            asm volatile("" : "+v"(op) :: "memory");
            u32x4 p[4][2];
#pragma unroll
            for (int m = 0; m < 4; ++m)
#pragma unroll
                for (int bj = 0; bj < 2; ++bj) { if (br != 0) p[m][bj] = *(const u32x4*)(op + (size_t)(m * 16) * ldo + bj * HALF); else p[m][bj] = (u32x4){0u, 0u, 0u, 0u}; }
#pragma unroll
            for (int m = 0; m < 4; ++m)
#pragma unroll
                for (int bj = 0; bj < 2; ++bj) { const u32x2 gg = g[ai][m][bj]; const u32x4 pp = p[m][bj];
                    f32x4 v0 = acc[ai][bj][m][0], v1 = acc[ai][bj][m][1];
                    v0[0] = v0[0] * ((float)(gg.x & 0xffu) * S) + bflo(pp.x); v0[1] = v0[1] * ((float)((gg.x >> 8) & 0xffu) * S) + bfhi(pp.x);
                    v0[2] = v0[2] * ((float)((gg.x >> 16) & 0xffu) * S) + bflo(pp.y); v0[3] = v0[3] * ((float)(gg.x >> 24) * S) + bfhi(pp.y);
                    v1[0] = v1[0] * ((float)(gg.y & 0xffu) * S) + bflo(pp.z); v1[1] = v1[1] * ((float)((gg.y >> 8) & 0xffu) * S) + bfhi(pp.z);
                    v1[2] = v1[2] * ((float)((gg.y >> 16) & 0xffu) * S) + bflo(pp.w); v1[3] = v1[3] * ((float)(gg.y >> 24) * S) + bfhi(pp.w);
                    if (br == 3) { int lo8 = 0, hi8 = 0; lo8 = __builtin_amdgcn_cvt_pk_fp8_f32(v0[0], v0[1], lo8, false); lo8 = __builtin_amdgcn_cvt_pk_fp8_f32(v0[2], v0[3], lo8, true);
                        hi8 = __builtin_amdgcn_cvt_pk_fp8_f32(v1[0], v1[1], hi8, false); hi8 = __builtin_amdgcn_cvt_pk_fp8_f32(v1[2], v1[3], hi8, true);
                        *(u32x2*)(O8 + ((size_t)((op - O) + (size_t)(m * 16) * ldo + bj * HALF))) = (u32x2){(unsigned)lo8, (unsigned)hi8}; }
                    else { u32x4 w; w.x = cvt_pk_bf16(v0[0], v0[1]); w.y = cvt_pk_bf16(v0[2], v0[3]); w.z = cvt_pk_bf16(v1[0], v1[1]); w.w = cvt_pk_bf16(v1[2], v1[3]);
                        *(u32x4*)(op + (size_t)(m * 16) * ldo + bj * HALF) = w; } }
            op += (size_t)HALF * ldo;
        }
    }
};
struct MergeOrder {
    int ntiles, nrt, G, c;
    __device__ __forceinline__ bool next(int i, Unit& u) const {
        const int t = (i >> 2) * G + c, br = i & 3; if (t >= ntiles) return false;
        u.pm = br * nrt + (t >> 2); u.pn = t & 3; u.bn = br * 4 + (t & 3); return true; }
    static constexpr bool GATHER = false;
    __device__ __forceinline__ int a_tile(const Unit& u) const { return u.pm; }
    __device__ __forceinline__ size_t k_off(const Unit&) const { return 0; }
    __device__ __forceinline__ bool carry(const Unit& u) const { return u.pm / nrt == 1; }
    __device__ __forceinline__ void a_ready(const Unit&) const {}
    __device__ __forceinline__ void done(const Unit&) const {}
};
struct EpiSwiGLU {
    static constexpr bool PERM = true, AFTER_DRAIN = false;
    bf16_t* O; int ldo;
    __device__ __forceinline__ void operator()(const f32x4 (&acc)[2][2][4][2], const Unit& u, int wr, int wc, int fr, int fq) const {
        const int row0 = u.pm * BM + wr * 64 + fr, col0 = u.pn * HALF + wc * 32 + 8 * fq;
#pragma unroll
        for (int ai = 0; ai < 2; ++ai)
#pragma unroll
            for (int m = 0; m < 4; ++m) {
                f32x4 g0 = acc[ai][0][m][0], g1 = acc[ai][0][m][1]; const f32x4 u0 = acc[ai][1][m][0], u1 = acc[ai][1][m][1];
#pragma unroll
                for (int j = 0; j < 4; ++j) { g0[j] = g0[j] * fsigmoid(g0[j]) * u0[j]; g1[j] = g1[j] * fsigmoid(g1[j]) * u1[j]; }
                u32x4 w; w.x = cvt_pk_bf16(g0[0], g0[1]); w.y = cvt_pk_bf16(g0[2], g0[3]); w.z = cvt_pk_bf16(g1[0], g1[1]); w.w = cvt_pk_bf16(g1[2], g1[3]);
                *(u32x4*)(O + (size_t)(row0 + ai * HALF + m * 16) * ldo + col0) = w; }
    }
};
struct EpiSwiGLU8 {
    static constexpr bool PERM = true, AFTER_DRAIN = false;
    unsigned char* O; int ldo; float s;
    __device__ __forceinline__ void operator()(const f32x4 (&acc)[2][2][4][2], const Unit& u, int wr, int wc, int fr, int fq) const {
        typedef unsigned u32x2 __attribute__((ext_vector_type(2)));
        const int row0 = u.pm * BM + wr * 64 + fr, col0 = u.pn * HALF + wc * 32 + 8 * fq;
#pragma unroll
        for (int ai = 0; ai < 2; ++ai)
#pragma unroll
            for (int m = 0; m < 4; ++m) {
                f32x4 g0 = acc[ai][0][m][0] * s, g1 = acc[ai][0][m][1] * s; const f32x4 u0 = acc[ai][1][m][0] * s, u1 = acc[ai][1][m][1] * s;
#pragma unroll
                for (int j = 0; j < 4; ++j) { g0[j] = g0[j] * fsigmoid(g0[j]) * u0[j]; g1[j] = g1[j] * fsigmoid(g1[j]) * u1[j]; }
                int lo = 0, hi = 0;
                lo = __builtin_amdgcn_cvt_pk_fp8_f32(g0[0], g0[1], lo, false); lo = __builtin_amdgcn_cvt_pk_fp8_f32(g0[2], g0[3], lo, true);
                hi = __builtin_amdgcn_cvt_pk_fp8_f32(g1[0], g1[1], hi, false); hi = __builtin_amdgcn_cvt_pk_fp8_f32(g1[2], g1[3], hi, true);
                *(u32x2*)(O + (size_t)(row0 + ai * HALF + m * 16) * ldo + col0) = (u32x2){(unsigned)lo, (unsigned)hi};
                __builtin_amdgcn_sched_barrier(0); }
    }
};
struct EpiBf16S {
    static constexpr bool PERM = true, AFTER_DRAIN = false;
    bf16_t* O; int ldc; float s;
    __device__ __forceinline__ void operator()(const f32x4 (&acc)[2][2][4][2], const Unit& u, int wr, int wc, int fr, int fq) const {
        const int row0 = u.pm * BM + wr * 64 + fr, col0 = u.pn * BM + wc * 32 + 8 * fq;
#pragma unroll
        for (int ai = 0; ai < 2; ++ai)
#pragma unroll
            for (int m = 0; m < 4; ++m) { bf16_t* rowp = O + (size_t)(row0 + ai * HALF + m * 16) * ldc + col0;
#pragma unroll
                for (int bj = 0; bj < 2; ++bj) { const f32x4 v0 = acc[ai][bj][m][0] * s, v1 = acc[ai][bj][m][1] * s;
                    u32x4 w; w.x = cvt_pk_bf16(v0[0], v0[1]); w.y = cvt_pk_bf16(v0[2], v0[3]); w.z = cvt_pk_bf16(v1[0], v1[1]); w.w = cvt_pk_bf16(v1[2], v1[3]);
                    *(u32x4*)(rowp + bj * HALF) = w; } }
    }
};
struct EpiG8 {
    static constexpr bool PERM = true, AFTER_DRAIN = false;
    unsigned char* G8; int ldg; float s;
    __device__ __forceinline__ void operator()(const f32x4 (&acc)[2][2][4][2], const Unit& u, int wr, int wc, int fr, int fq) const {
        const int row0 = u.pm * BM + wr * 64 + fr, col0 = u.pn * BM + wc * 32 + 8 * fq;
#pragma unroll
        for (int ai = 0; ai < 2; ++ai)
#pragma unroll
            for (int m = 0; m < 4; ++m) { unsigned char* rowp = G8 + (size_t)(row0 + ai * HALF + m * 16) * ldg + col0;
#pragma unroll
                for (int bj = 0; bj < 2; ++bj) { const f32x4 v0 = acc[ai][bj][m][0] * s, v1 = acc[ai][bj][m][1] * s; unsigned lo = 0u, hi = 0u;
                    lo = __builtin_amdgcn_cvt_pk_u8_f32(255.0f * fsigmoid(v0[0]), 0, lo); lo = __builtin_amdgcn_cvt_pk_u8_f32(255.0f * fsigmoid(v0[1]), 1, lo);
                    lo = __builtin_amdgcn_cvt_pk_u8_f32(255.0f * fsigmoid(v0[2]), 2, lo); lo = __builtin_amdgcn_cvt_pk_u8_f32(255.0f * fsigmoid(v0[3]), 3, lo);
                    hi = __builtin_amdgcn_cvt_pk_u8_f32(255.0f * fsigmoid(v1[0]), 0, hi); hi = __builtin_amdgcn_cvt_pk_u8_f32(255.0f * fsigmoid(v1[1]), 1, hi);
                    hi = __builtin_amdgcn_cvt_pk_u8_f32(255.0f * fsigmoid(v1[2]), 2, hi); hi = __builtin_amdgcn_cvt_pk_u8_f32(255.0f * fsigmoid(v1[3]), 3, hi);
                    typedef unsigned u32x2 __attribute__((ext_vector_type(2))); *(u32x2*)(rowp + bj * HALF) = (u32x2){lo, hi}; } }
    }
};
struct EpiF8S {
    static constexpr bool PERM = true, AFTER_DRAIN = false;
    unsigned char* O; int ldc; float s;
    __device__ __forceinline__ void operator()(const f32x4 (&acc)[2][2][4][2], const Unit& u, int wr, int wc, int fr, int fq) const {
        typedef unsigned u32x2 __attribute__((ext_vector_type(2)));
        const int row0 = u.pm * BM + wr * 64 + fr, col0 = u.pn * BM + wc * 32 + 8 * fq;
#pragma unroll
        for (int ai = 0; ai < 2; ++ai)
#pragma unroll
            for (int m = 0; m < 4; ++m) { unsigned char* rowp = O + (size_t)(row0 + ai * HALF + m * 16) * ldc + col0;
#pragma unroll
                for (int bj = 0; bj < 2; ++bj) { const f32x4 v0 = acc[ai][bj][m][0] * s, v1 = acc[ai][bj][m][1] * s; int lo = 0, hi = 0;
                    lo = __builtin_amdgcn_cvt_pk_fp8_f32(v0[0], v0[1], lo, false); lo = __builtin_amdgcn_cvt_pk_fp8_f32(v0[2], v0[3], lo, true);
                    hi = __builtin_amdgcn_cvt_pk_fp8_f32(v1[0], v1[1], hi, false); hi = __builtin_amdgcn_cvt_pk_fp8_f32(v1[2], v1[3], hi, true);
                    *(u32x2*)(rowp + bj * HALF) = (u32x2){(unsigned)lo, (unsigned)hi}; } }
    }
};
struct InprojOrder {
    StaticOrder base; int nextra, pm0;
    __device__ __forceinline__ bool next(int i, Unit& u) const {
        const long L = (long)i * base.G + base.c; if (L < base.nwg) return base.next(i, u);
        const int e = (int)(L - base.nwg); if (e >= nextra) return false;
        const int q = e / 3, x = e - 3 * q; u.pm = pm0 + q; u.pn = (x == 0) ? 5 : (x == 1 ? 7 : 8); u.bn = u.pn; return true; }
    static constexpr bool GATHER = false;
    __device__ __forceinline__ int a_tile(const Unit& u) const { return u.pm; }
    __device__ __forceinline__ size_t k_off(const Unit&) const { return 0; }
    __device__ __forceinline__ bool carry(const Unit&) const { return false; }
    __device__ __forceinline__ void a_ready(const Unit&) const {}
    __device__ __forceinline__ void done(const Unit&) const {}
};
struct MoeOrder {
    const PG8_LAS int* tile_e; int ntiles, G, c;
    __device__ __forceinline__ static void unit_of(int i, int G, int c, int& t, int& pn) {
        if (G == 256) { t = i * 64 + (c & 7) * 8 + (c >> 5); pn = (c >> 3) & 3; } else { const long L = (long)i * G + c; t = (int)(L >> 2); pn = (int)(L & 3); } }
    __device__ __forceinline__ bool next(int i, Unit& u) const {
        int t, pn; unit_of(i, G, c, t, pn); if (t >= ntiles) return false;
        u.pm = t; u.pn = pn; u.bn = __builtin_amdgcn_readfirstlane(tile_e[t]) * 4 + pn; return true; }
    static constexpr bool GATHER = false;
    __device__ __forceinline__ int a_tile(const Unit& u) const { return u.pm; }
    __device__ __forceinline__ size_t k_off(const Unit&) const { return 0; }
    __device__ __forceinline__ bool carry(const Unit&) const { return false; }
    __device__ __forceinline__ void a_ready(const Unit&) const {}
    __device__ __forceinline__ void done(const Unit&) const {}
};
struct MoeGatherOrder : MoeOrder {
    const PG8_LAS int* tok;
    static constexpr bool GATHER = true;
    __device__ __forceinline__ int a_tile(const Unit&) const { return 0; }
    __device__ __forceinline__ void offsets(int i, int tid, int K, unsigned (&out)[2][2]) const {
#pragma unroll
        for (int p = 0; p < 2; ++p) { int R, C; stage_rc(tid * 16 + p * 8192, R, C);
#pragma unroll
            for (int h = 0; h < 2; ++h) out[h][p] = (unsigned)(tok[i * 256 + h * 128 + R] * K + C) * 2u; } }
};

typedef int i32x4_ __attribute__((ext_vector_type(4))); typedef int i32x8_ __attribute__((ext_vector_type(8)));
template <class Epi, class Sched, bool ALIGN_EPI = false, bool SP2 = false, bool FP8 = false>
__device__ __forceinline__ void gemm_phase(PG8_LAS unsigned char* lds, const Gemm g, const Sched& S, const Epi& E, const int tid_in) {
    const int tid = tid_in, wid = __builtin_amdgcn_readfirstlane(tid >> 6), lane = tid & 63, wr = wid >> 2, wc = wid & 3, fr = lane & 15, fq = lane >> 4;
    const int K = g.K, nt = g.KT ? g.KT : K / BK;
    unsigned voffA[2], voffB[2];
#pragma unroll
    for (int i = 0; i < 2; ++i) { int R, C; stage_rc(tid * 16 + i * 8192, R, C); const int Rb = Epi::PERM ? ((R & ~31) + perm32(R & 31)) : R;
        voffA[i] = (unsigned)(R * K + C) * 2u; voffB[i] = (unsigned)(Rb * K + C) * 2u; }
    unsigned voC[2][2] = {{0u, 0u}, {0u, 0u}}, voN[2][2] = {{0u, 0u}, {0u, 0u}};
    const size_t kstep = (size_t)(BK * 2);
    const size_t hstep = (size_t)HALF * K * 2;
    const size_t tstep = 2 * hstep;
    const unsigned ldsw = (unsigned)wid * 1024u;
    const int aoff = lds_byte(wr * 64 + fr, fq * 8), boff = lds_byte(wc * 32 + fr, fq * 8);
#define PG8_SA(b, h) (((b) * 2 + (h)) * HTB)
#define PG8_SB(b, h) ((4 + (b) * 2 + (h)) * HTB)
#define PG8_STAGE(bufoff, gbase, voff) do { _Pragma("unroll") for (int _i = 0; _i < 2; ++_i) \
        __builtin_amdgcn_global_load_lds((const unsigned*)((const char*)(gbase) + (voff)[_i]), (PG8_LAS unsigned*)(lds + (bufoff) + ldsw + _i * 8192), 16, 0, 0); } while (0)
#define PG8_STAGE_A(bufoff, gptr, h, nx) do { if constexpr (Sched::GATHER) { const unsigned vsel_[2] = {(nx) ? voN[h][0] : voC[h][0], (nx) ? voN[h][1] : voC[h][1]}; PG8_STAGE(bufoff, gptr, vsel_); } \
        else { PG8_STAGE(bufoff, (gptr) + (h) * hstep, voffA); } } while (0)
#define PG8_LDA(dst, b, h) do { if constexpr (FP8) { _Pragma("unroll") for (int m = 0; m < 4; ++m) dst##8[m] = __builtin_shufflevector(*(const PG8_LAS i32x4_*)(lds + PG8_SA(b, h) + aoff + m * 2048), *(const PG8_LAS i32x4_*)(lds + PG8_SA(b, h) + aoff + m * 2048 + 1024), 0, 1, 2, 3, 4, 5, 6, 7); } \
        else { _Pragma("unroll") for (int m = 0; m < 4; ++m) _Pragma("unroll") for (int k = 0; k < 2; ++k) dst[m][k] = *(const PG8_LAS bf16x8*)(lds + PG8_SA(b, h) + aoff + m * 2048 + k * 1024); } } while (0)
#define PG8_LDB(dst, b, h) do { if constexpr (FP8) { _Pragma("unroll") for (int n = 0; n < 2; ++n) dst##8[n] = __builtin_shufflevector(*(const PG8_LAS i32x4_*)(lds + PG8_SB(b, h) + boff + n * 2048), *(const PG8_LAS i32x4_*)(lds + PG8_SB(b, h) + boff + n * 2048 + 1024), 0, 1, 2, 3, 4, 5, 6, 7); } \
        else { _Pragma("unroll") for (int n = 0; n < 2; ++n) _Pragma("unroll") for (int k = 0; k < 2; ++k) dst[n][k] = *(const PG8_LAS bf16x8*)(lds + PG8_SB(b, h) + boff + n * 2048 + k * 1024); } } while (0)
#define PG8_MMA(ai, bj, At, Bt) do { __builtin_amdgcn_s_setprio(1); if constexpr (FP8) { _Pragma("unroll") for (int m = 0; m < 4; ++m) _Pragma("unroll") for (int n = 0; n < 2; ++n) \
            asm volatile("v_mfma_f32_16x16x128_f8f6f4 %0, %1, %2, %0" : "+v"(acc[ai][bj][m][n]) : "v"(Bt##8[n]), "v"(At##8[m])); }     \
        else { _Pragma("unroll") for (int m = 0; m < 4; ++m) _Pragma("unroll") for (int n = 0; n < 2; ++n) _Pragma("unroll") for (int k = 0; k < 2; ++k) \
        acc[ai][bj][m][n] = __builtin_amdgcn_mfma_f32_16x16x32_bf16(Bt[n][k], At[m][k], acc[ai][bj][m][n], 0, 0, 0); } __builtin_amdgcn_s_setprio(0); } while (0)
#define PG8_WAIT_V(n) asm volatile("s_waitcnt vmcnt(" #n ")" ::: "memory")
#define PG8_WAIT_L(n) asm volatile("s_waitcnt lgkmcnt(" #n ")" ::: "memory")
#define PG8_BAR __builtin_amdgcn_s_barrier()
#define PG8_SCHED __builtin_amdgcn_sched_barrier(0)
    Unit cur{}, nxt{}; int ui = 0;
    if (!S.next(0, cur)) return;
    f32x4 acc[2][2][4][2];
#pragma unroll
    for (int a = 0; a < 2; ++a)
#pragma unroll
        for (int b = 0; b < 2; ++b)
#pragma unroll
            for (int m = 0; m < 4; ++m)
#pragma unroll
                for (int n = 0; n < 2; ++n) acc[a][b][m][n] = (f32x4){0.f, 0.f, 0.f, 0.f};
    bf16x8 At[4][2], B0[2][2], B1[2][2]; i32x8_ At8[4], B08[2], B18[2];
    if constexpr (Sched::GATHER) S.offsets(0, tid, K, voC);
    const char* cA = (const char*)g.A + (size_t)S.a_tile(cur) * tstep + S.k_off(cur); const char* cB = (const char*)g.Bt + (size_t)cur.bn * tstep + S.k_off(cur);
    S.a_ready(cur);
    if constexpr (SP2) {
        PG8_STAGE(PG8_SB(0, 0), cB, voffB); PG8_STAGE(PG8_SB(0, 1), cB + hstep, voffB); PG8_STAGE_A(PG8_SA(0, 0), cA, 0, false); PG8_STAGE_A(PG8_SA(0, 1), cA, 1, false);
        if (wr == 1) PG8_BAR;
        PG8_WAIT_V(2); PG8_BAR;
        PG8_STAGE(PG8_SB(1, 0), cB + kstep, voffB); PG8_STAGE_A(PG8_SA(1, 0), cA + kstep, 0, false); PG8_STAGE(PG8_SB(1, 1), cB + hstep + kstep, voffB);
        PG8_WAIT_V(6); PG8_BAR;
    } else {
        PG8_STAGE(PG8_SB(0, 0), cB, voffB); PG8_STAGE_A(PG8_SA(0, 0), cA, 0, false); PG8_STAGE(PG8_SB(0, 1), cB + hstep, voffB); PG8_STAGE_A(PG8_SA(0, 1), cA, 1, false);
        if (wr == 1) PG8_BAR;
        PG8_WAIT_V(4); PG8_BAR;
        PG8_STAGE(PG8_SB(1, 0), cB + kstep, voffB); PG8_STAGE_A(PG8_SA(1, 0), cA + kstep, 0, false); PG8_STAGE(PG8_SB(1, 1), cB + hstep + kstep, voffB);
        PG8_WAIT_V(6); PG8_BAR;
    }
    for (;;) {
        const bool has_next = S.next(ui + 1, nxt);
        const char* nA = has_next ? (const char*)g.A + (size_t)S.a_tile(nxt) * tstep + S.k_off(nxt) : cA; const char* nB = has_next ? (const char*)g.Bt + (size_t)nxt.bn * tstep + S.k_off(nxt) : cB;
        for (int t = 0; t < nt; t += 2) {
            const bool last = (t == nt - 2);
            const char* a1 = cA + (size_t)(t + 1) * kstep;
            const char* a2 = last ? nA : cA + (size_t)(t + 2) * kstep; const char* b2 = last ? nB : cB + (size_t)(t + 2) * kstep;
            const char* a3 = a2 + kstep; const char* b3 = b2 + kstep;
            const bool nxu = last && has_next;
            if (last && has_next) { S.a_ready(nxt); if constexpr (Sched::GATHER) S.offsets(ui + 1, tid, K, voN); }
            if constexpr (SP2) {
            PG8_LDB(B0, 0, 0); PG8_LDB(B1, 0, 1); PG8_SCHED; PG8_LDA(At, 0, 0); PG8_STAGE_A(PG8_SA(1, 1), a1, 1, false);
            PG8_WAIT_V(8); PG8_WAIT_L(0); PG8_BAR; PG8_MMA(0, 0, At, B0); PG8_MMA(0, 1, At, B1); PG8_BAR; PG8_SCHED;
            PG8_LDA(At, 0, 1); PG8_STAGE(PG8_SB(0, 0), b2, voffB); PG8_STAGE(PG8_SB(0, 1), b2 + hstep, voffB); PG8_STAGE_A(PG8_SA(0, 0), a2, 0, nxu);
            PG8_WAIT_V(8); PG8_WAIT_L(0); PG8_BAR; PG8_MMA(1, 0, At, B0); PG8_MMA(1, 1, At, B1); PG8_BAR; PG8_SCHED;
            PG8_LDB(B0, 1, 0); PG8_LDB(B1, 1, 1); PG8_SCHED; PG8_LDA(At, 1, 0); PG8_STAGE_A(PG8_SA(0, 1), a2, 1, nxu);
            PG8_WAIT_V(8); PG8_WAIT_L(0); PG8_BAR; PG8_MMA(0, 0, At, B0); PG8_MMA(0, 1, At, B1); PG8_BAR; PG8_SCHED;
            PG8_LDA(At, 1, 1); PG8_STAGE(PG8_SB(1, 0), b3, voffB); PG8_STAGE(PG8_SB(1, 1), b3 + hstep, voffB); PG8_STAGE_A(PG8_SA(1, 0), a3, 0, nxu);
            PG8_WAIT_V(8); PG8_WAIT_L(0); PG8_BAR; PG8_MMA(1, 0, At, B0); PG8_MMA(1, 1, At, B1); PG8_BAR; PG8_SCHED;
            } else {
            PG8_LDB(B0, 0, 0); PG8_SCHED; PG8_LDA(At, 0, 0); PG8_STAGE_A(PG8_SA(1, 1), a1, 1, false);
            PG8_WAIT_L(8); PG8_BAR; PG8_WAIT_L(0); PG8_MMA(0, 0, At, B0); PG8_BAR; PG8_SCHED;
            PG8_LDB(B1, 0, 1); PG8_STAGE(PG8_SB(0, 0), b2, voffB);
            PG8_BAR; PG8_WAIT_L(0); PG8_MMA(0, 1, At, B1); PG8_BAR;
            PG8_LDA(At, 0, 1); PG8_STAGE_A(PG8_SA(0, 0), a2, 0, nxu);
            PG8_BAR; PG8_WAIT_L(0); PG8_MMA(1, 0, At, B0); PG8_BAR; PG8_SCHED;
            PG8_STAGE(PG8_SB(0, 1), b2 + hstep, voffB);
            PG8_WAIT_V(6); PG8_BAR; PG8_MMA(1, 1, At, B1); PG8_BAR;
            PG8_LDB(B0, 1, 0); PG8_SCHED; PG8_LDA(At, 1, 0); PG8_STAGE_A(PG8_SA(0, 1), a2, 1, nxu);
            PG8_WAIT_L(8); PG8_BAR; PG8_WAIT_L(0); PG8_MMA(0, 0, At, B0); PG8_BAR; PG8_SCHED;
            PG8_LDB(B1, 1, 1); PG8_STAGE(PG8_SB(1, 0), b3, voffB);
            PG8_BAR; PG8_WAIT_L(0); PG8_MMA(0, 1, At, B1); PG8_BAR;
            PG8_LDA(At, 1, 1); PG8_STAGE_A(PG8_SA(1, 0), a3, 0, nxu);
            PG8_BAR; PG8_WAIT_L(0); PG8_MMA(1, 0, At, B0); PG8_BAR; PG8_SCHED;
            PG8_STAGE(PG8_SB(1, 1), b3 + hstep, voffB);
            PG8_WAIT_V(6); PG8_BAR; PG8_MMA(1, 1, At, B1); PG8_BAR;
            }
        }
        if constexpr (ALIGN_EPI) { if (wr == 0) PG8_BAR; }
        if constexpr (FP8) asm volatile("s_nop 15\n\ts_nop 15" ::: "memory");
        const bool carry = S.carry(cur);
        if constexpr (!Epi::AFTER_DRAIN) { if (!carry) { int lane_e_; asm volatile("v_mbcnt_lo_u32_b32 %0, -1, 0\n\tv_mbcnt_hi_u32_b32 %0, -1, %0" : "=v"(lane_e_));
            E(acc, cur, wr, wc, lane_e_ & 15, lane_e_ >> 4); } S.done(cur); }
        if (!has_next) break;
        if (!carry && !(epi_probe_flags<Epi>::v & 1))
#pragma unroll
        for (int a = 0; a < 2; ++a)
#pragma unroll
            for (int b = 0; b < 2; ++b)
#pragma unroll
                for (int m = 0; m < 4; ++m)
#pragma unroll
                    for (int n = 0; n < 2; ++n) acc[a][b][m][n] = (f32x4){0.f, 0.f, 0.f, 0.f};
        cur = nxt; cA = nA; cB = nB; ++ui;
        if constexpr (Sched::GATHER) { voC[0][0] = voN[0][0]; voC[0][1] = voN[0][1]; voC[1][0] = voN[1][0]; voC[1][1] = voN[1][1]; }
        if constexpr (ALIGN_EPI) { if (wr == 1) PG8_BAR; }
    }
    PG8_WAIT_V(0);
    if constexpr (!ALIGN_EPI) { if (wr == 0) PG8_BAR; }
    PG8_BAR;
    if constexpr (Epi::AFTER_DRAIN) { E.fused(acc, cur, wr, wc, fr, fq, lds, wid, lane); S.done(cur); }
#undef PG8_SA
#undef PG8_SB
#undef PG8_STAGE
#undef PG8_LDA
#undef PG8_LDB
#undef PG8_MMA
#undef PG8_WAIT_V
#undef PG8_WAIT_L
#undef PG8_BAR
#undef PG8_SCHED
}
}

constexpr int D = 1024, NBATCH = 8, SEQ = 4096, CTXL = 256, DEPTH = 2;
constexpr int NLAT = NBATCH * SEQ, NCTX = NBATCH * CTXL, MTOT = NLAT + NCTX;
constexpr int IN_COLS = 5648;
constexpr int ZC = 2560;
constexpr int ZW = 5632;
constexpr int NGC = 3072;
constexpr int ZN = 5888;
constexpr int Z_AB = 0, Z_AC = 256, Z_AX = 512, Z_Q = 768, Z_K = 1280, Z_V = 1408, Z_MQ = 1536, Z_MK = 1792, Z_MV = 2048, Z_MO = 2304, Z_MG = 2560;
constexpr int NEXP = 32, DEXP = 512, PMAX = 77824;
constexpr int NCHUNK = 68, NSCAN = 64;
constexpr float LN_EPS = 1e-6f;
constexpr float WQ_SCALE = 32.0f, WQ_INV = 1.0f / 32.0f;
constexpr float DN_ALPHA = 1.4142135623730951f;
constexpr int NWAVES = 8, NTHREADS = 512;

constexpr size_t MiB = 1u << 20;
constexpr size_t WS_CTL = 0, CTL_ZERO_BYTES = 1 * MiB;
constexpr size_t WS_MOD = 1 * MiB;
constexpr size_t WS_ROPE = 1 * MiB + 512 * 1024;
constexpr size_t WS_GATES = 2 * MiB;
constexpr size_t WS_EID = 5 * MiB;
constexpr size_t WS_WTS = 5 * MiB + 512 * 1024;
constexpr size_t WS_SLOT = 6 * MiB;
constexpr size_t WS_CNT = 6 * MiB + 512 * 1024;
constexpr size_t WS_MG = 7 * MiB;
constexpr size_t WS_NST = 8 * MiB;
constexpr size_t WS_WR = 12 * MiB;
constexpr size_t WS_TOK = 13 * MiB;
constexpr size_t WS_W = 16 * MiB;
constexpr size_t W_IN = 0, W_IN_B = (size_t)ZN * D * 2;
constexpr size_t W_PA = W_IN + W_IN_B, W_PA_B = (size_t)D * 256 * 2;
constexpr size_t W_PB = W_PA + W_PA_B, W_PB_B = (size_t)D * 512 * 2;
constexpr size_t W_PC = W_PB + W_PB_B, W_PC_B = (size_t)D * 256 * 2;
constexpr size_t W_O = W_PC + W_PC_B, W_O_B = (size_t)D * D * 2;
constexpr size_t W_EI = W_O + W_O_B, W_EI_B = (size_t)NEXP * D * D;
constexpr size_t W_EO = W_EI + W_EI_B, W_EO_B = (size_t)NEXP * D * DEXP;
constexpr size_t W_G8 = W_EO + W_EO_B, W_G8_B = (size_t)NGC * D;
constexpr size_t W_O8 = W_G8 + W_G8_B, W_O8_B = (size_t)D * D;
constexpr size_t W_LAYER = W_O8 + W_O8_B;
constexpr size_t WS_H8 = 170 * MiB;
constexpr size_t WS_XA = 240 * MiB;
constexpr size_t WS_XAL = WS_XA + 68 * MiB;
constexpr size_t WS_H = 376 * MiB;
constexpr size_t WS_Z = 444 * MiB;
constexpr size_t WS_GU8 = WS_Z + 170 * MiB;
constexpr size_t WS_XG = WS_Z, WS_ACT = WS_Z + 152 * MiB;
constexpr size_t WS_TOKE = WS_Z + 280 * MiB;
static_assert(WS_GU8 + (size_t)MTOT * 3072 <= WS_TOKE && WS_TOKE + (size_t)32 * MTOT * 4 <= 818 * MiB, "ws map toke");
constexpr size_t WS_YA = 818 * MiB;
constexpr size_t WS_YB = WS_YA + (size_t)MTOT * 256 * 2, WS_YC = WS_YB + (size_t)MTOT * 512 * 2, WS_YL = WS_YA;
constexpr size_t WS_MERGED = 886 * MiB;
constexpr size_t WS_CST = WS_MERGED;
constexpr size_t WS_CSTB = 954 * MiB;
constexpr size_t WS_HLO = 954 * MiB;
constexpr size_t WS_MERGED8 = WS_HLO;
constexpr size_t WS_END = 1022 * MiB;
static_assert(WS_NST + (size_t)NSCAN * NCHUNK * 64 * 4 <= WS_WR && WS_WR + 2 * 2 * 48 * 1024 * 2 <= WS_W && WS_MG + 3 * NSCAN * NCHUNK * 4 <= WS_NST && WS_GATES + (size_t)MTOT * 16 * 4 <= WS_EID, "ws map 0");
static_assert(WS_W + 2 * W_LAYER <= WS_H8 && WS_H8 + (size_t)MTOT * D <= WS_XA && WS_XA + (size_t)MTOT * D * 4 <= WS_H && WS_H + (size_t)MTOT * D * 2 <= WS_Z && WS_Z + (size_t)MTOT * ZC * 2 <= WS_GU8 && WS_GU8 + (size_t)MTOT * NGC <= WS_YA, "ws map 1");
static_assert(WS_YC + (size_t)MTOT * 256 * 2 <= WS_MERGED && WS_MERGED + (size_t)MTOT * D * 2 <= WS_HLO && WS_HLO + (size_t)MTOT * D * 2 <= WS_END && WS_CST + (size_t)NSCAN * NCHUNK * 4096 * 4 <= WS_END, "ws map 2");
static_assert(WS_ACT + (size_t)PMAX * DEXP * 2 <= WS_YA && WS_XG + (size_t)PMAX * D * 2 <= WS_ACT, "ws map 3");
constexpr int CW_BAR = 4096;
constexpr int CW_CNTG = 64;

constexpr int LDS_BYTES = 163840;
constexpr int LDS_RW = 0;
constexpr int LDS_SMALL = 147456;
constexpr int LDS_HIST = LDS_SMALL;
constexpr int LDS_TOT = LDS_SMALL + 128, LDS_BELOW = LDS_SMALL + 256, LDS_BASE = LDS_SMALL + 384, LDS_FILL = LDS_SMALL + 512;
constexpr int LDS_BIAS = LDS_SMALL + 640;
constexpr int LDS_TILE_E = LDS_SMALL + 1024;
constexpr int LDS_PAIRS = LDS_SMALL + 2560;
constexpr int LDS_TOKTAB = LDS_SMALL + 5120;
constexpr int LDS_MISC = LDS_BYTES - 128;

#define GAS __attribute__((address_space(1)))
#define LAS __attribute__((address_space(3)))
typedef unsigned short bf16;
typedef unsigned v4u __attribute__((ext_vector_type(4)));
typedef unsigned v2u __attribute__((ext_vector_type(2)));
typedef float f32x4 __attribute__((ext_vector_type(4)));
typedef float f32x16 __attribute__((ext_vector_type(16)));
typedef short bf16x8 __attribute__((ext_vector_type(8)));
typedef short s16x4 __attribute__((ext_vector_type(4)));
typedef GAS unsigned gu32;
#define RLX_AGENT __ATOMIC_RELAXED, __HIP_MEMORY_SCOPE_AGENT
#define LDS_WAIT() asm volatile("s_waitcnt lgkmcnt(0)" ::: "memory")
#define VM_WAIT() asm volatile("s_waitcnt vmcnt(0)" ::: "memory")
__device__ __forceinline__ unsigned pk2(float lo, float hi) { unsigned r; asm("v_cvt_pk_bf16_f32 %0, %1, %2" : "=v"(r) : "v"(lo), "v"(hi)); return r; }
__device__ __forceinline__ float bflo(unsigned w) { return __uint_as_float(w << 16); }
__device__ __forceinline__ float bfhi(unsigned w) { return __uint_as_float(w & 0xffff0000u); }
__device__ __forceinline__ float bf2f(bf16 b) { return __uint_as_float((unsigned)b << 16); }
__device__ __forceinline__ float fsig(float x) { return __builtin_amdgcn_rcpf(1.0f + __expf(-x)); }
__device__ __forceinline__ float dpp_f(float v, const int ctrl_sel) {
    const int x = __builtin_bit_cast(int, v); int r;
    switch (ctrl_sel) { case 0: r = __builtin_amdgcn_update_dpp(x, x, 0xB1, 0xF, 0xF, false); break;
                        case 1: r = __builtin_amdgcn_update_dpp(x, x, 0x4E, 0xF, 0xF, false); break;
                        case 2: r = __builtin_amdgcn_update_dpp(x, x, 0x141, 0xF, 0xF, false); break;
                        default: r = __builtin_amdgcn_update_dpp(x, x, 0x140, 0xF, 0xF, false); break; }
    return __builtin_bit_cast(float, r);
}
__device__ __forceinline__ float rl_f(float v, int lane) { return __builtin_bit_cast(float, __builtin_amdgcn_readlane(__builtin_bit_cast(int, v), lane)); }
__device__ __forceinline__ float wave_sum(float v) {
    v += dpp_f(v, 0); v += dpp_f(v, 1); v += dpp_f(v, 2); v += dpp_f(v, 3);
    return (rl_f(v, 0) + rl_f(v, 16)) + (rl_f(v, 32) + rl_f(v, 48));
}
__device__ __forceinline__ float wave_max(float v) {
    v = fmaxf(v, dpp_f(v, 0)); v = fmaxf(v, dpp_f(v, 1)); v = fmaxf(v, dpp_f(v, 2)); v = fmaxf(v, dpp_f(v, 3));
    return fmaxf(fmaxf(rl_f(v, 0), rl_f(v, 16)), fmaxf(rl_f(v, 32), rl_f(v, 48)));
}
__device__ __forceinline__ bf16x8 tr_frag(const LAS bf16* plo, const LAS bf16* phi) {
    const s16x4 lo = __builtin_amdgcn_ds_read_tr16_b64_v4i16((LAS s16x4*)plo), hi = __builtin_amdgcn_ds_read_tr16_b64_v4i16((LAS s16x4*)phi);
    return (bf16x8){lo[0], lo[1], lo[2], lo[3], hi[0], hi[1], hi[2], hi[3]};
}
#define MFMA32(a, b, c) __builtin_amdgcn_mfma_f32_32x32x16_bf16((a), (b), (c), 0, 0, 0)

struct Frame {
    LAS unsigned char* lds;
    int tid, lane, wave, G, bid;
    const float* const* in;
    float* out; unsigned char* ws;
};
enum { I_X = 0, I_C, I_CTX, I_CCTX, I_WADA, I_BADA, I_WIN, I_CONVW, I_SINK, I_GATEB, I_NORMW, I_WPA, I_WPB, I_WPC, I_WOUT, I_LN1G, I_LN1B, I_WRG, I_BRG, I_WRE, I_BRE, I_WEI, I_WEO, I_LN2G, I_LN2B };

__device__ __forceinline__ void p0_transpose_item(const float* W, int ldw, int K, int c0, int k0, bf16* WT, int r0, LAS float* scr, int lane) {
    f32x4 tv[16];
#pragma unroll
    for (int i = 0; i < 16; ++i) tv[i] = *(const f32x4*)(W + (size_t)(k0 + 4 * i + (lane >> 4)) * ldw + c0 + 4 * (lane & 15));
#pragma unroll
    for (int i = 0; i < 16; ++i) { LAS float* w = scr + (4 * i + (lane >> 4)) * 65 + 4 * (lane & 15); w[0] = tv[i].x; w[1] = tv[i].y; w[2] = tv[i].z; w[3] = tv[i].w; }
    LDS_WAIT(); asm volatile("" ::: "memory");
    const int c = lane >> 3;
#pragma unroll
    for (int j = 0; j < 8; ++j) { const int n = (lane & 7) + 8 * j; const LAS float* s = scr + (8 * c) * 65 + n;
        v4u o; o.x = pk2(s[0 * 65], s[1 * 65]); o.y = pk2(s[2 * 65], s[3 * 65]); o.z = pk2(s[4 * 65], s[5 * 65]); o.w = pk2(s[6 * 65], s[7 * 65]);
        *(GAS v4u*)(WT + (size_t)(r0 + n) * K + k0 + 8 * c) = o; }
    LDS_WAIT(); asm volatile("" ::: "memory");
}

#ifdef FP8_SELFTEST
typedef int v8i_t __attribute__((ext_vector_type(8)));
#ifndef FP8_BROKEN
#define FP8_BROKEN 0
#endif
__device__ __forceinline__ unsigned fp8_of_small(int v) { return v == 0 ? 0x00u : (v == 1 ? 0x38u : (v == 2 ? 0x40u : 0x44u)); }
__device__ __forceinline__ unsigned st_h(unsigned x) { x *= 2654435761u; x ^= x >> 15; x *= 2246822519u; x ^= x >> 13; return x; }
__device__ __forceinline__ int st_a(int r, int g, int i) { return (int)(st_h((unsigned)(r * 131 + g * 17 + i * 3 + 1)) & 3u); }
__device__ __forceinline__ int st_b(int c, int g, int i) { return (int)(st_h((unsigned)(c * 113 + g * 29 + i * 7 + 5)) & 3u); }
__device__ __forceinline__ bool fp8_selftest(int lane) {
    const int rc = lane & 15, g = lane >> 4;
    v8i_t A, B;
#pragma unroll
    for (int d = 0; d < 8; ++d) { unsigned wa = 0u, wb = 0u;
#pragma unroll
        for (int b = 0; b < 4; ++b) { const int i = 4 * d + b; wa |= fp8_of_small(st_a(rc, g, i)) << (8 * b); wb |= fp8_of_small(st_b(rc, FP8_BROKEN ? (g ^ 1) : g, i)) << (8 * b); }
        A[d] = (int)wa; B[d] = (int)wb; }
    f32x4 c = {0.f, 0.f, 0.f, 0.f};
    c = __builtin_amdgcn_mfma_scale_f32_16x16x128_f8f6f4(A, B, c, 0, 0, 0, FP8_SELFTEST, 0, FP8_SELFTEST);
    bool ok = true;
#pragma unroll
    for (int q = 0; q < 4; ++q) { const int r = 4 * g + q, col = rc; int s = 0;
        for (int gg = 0; gg < 4; ++gg) for (int i = 0; i < 32; ++i) s += st_a(r, gg, i) * st_b(col, gg, i);
        ok = ok && (c[q] == (float)s); }
#ifdef FP8_FORCEFAIL
    ok = false;
#endif
    return __all(ok);
}
#endif
__device__ __forceinline__ void p0_transpose_item8(const float* W, int ldw, int K, int c0, int k0, unsigned char* WT, int r0, LAS float* scr, int lane, int mode = 0) {
    f32x4 tv[16];
#pragma unroll
    for (int i = 0; i < 16; ++i) tv[i] = (mode == 2) ? (f32x4){1.f, 2.f, 3.f, (float)(lane + i)} : *(const f32x4*)(W + (size_t)(k0 + 4 * i + (lane >> 4)) * ldw + c0 + 4 * (lane & 15));
#pragma unroll
    for (int i = 0; i < 16; ++i) { LAS float* w = scr + (4 * i + (lane >> 4)) * 65 + 4 * (lane & 15); w[0] = tv[i].x; w[1] = tv[i].y; w[2] = tv[i].z; w[3] = tv[i].w; }
    LDS_WAIT(); asm volatile("" ::: "memory");
    const int c = lane >> 3;
#pragma unroll
    for (int j = 0; j < 8; ++j) { const int n = (lane & 7) + 8 * j; const LAS float* s = scr + (8 * c) * 65 + n;
        int lo = 0, hi = 0;
        lo = __builtin_amdgcn_cvt_pk_fp8_f32(s[0 * 65] * WQ_SCALE, s[1 * 65] * WQ_SCALE, lo, false); lo = __builtin_amdgcn_cvt_pk_fp8_f32(s[2 * 65] * WQ_SCALE, s[3 * 65] * WQ_SCALE, lo, true);
        hi = __builtin_amdgcn_cvt_pk_fp8_f32(s[4 * 65] * WQ_SCALE, s[5 * 65] * WQ_SCALE, hi, false); hi = __builtin_amdgcn_cvt_pk_fp8_f32(s[6 * 65] * WQ_SCALE, s[7 * 65] * WQ_SCALE, hi, true);
        v2u o; o.x = (unsigned)lo; o.y = (unsigned)hi;
        if (mode == 0) *(GAS v2u*)(WT + (size_t)(r0 + n) * K + k0 + 8 * c) = o; else asm volatile("" :: "v"(o.x), "v"(o.y)); }
    LDS_WAIT(); asm volatile("" ::: "memory");
}
__device__ __forceinline__ void p0_prologue(Frame& F, int mode = 0) {
    {
        LAS float* sv = (LAS float*)(F.lds);
        LAS float* red = (LAS float*)(F.lds + 9 * 1024 * 4);
        bool have = false;
        for (int u = F.bid; u < ((mode == 4) ? 0 : 192); u += F.G) {
            if (!have) {
                for (int i = F.tid; i < 9 * 1024; i += NTHREADS) { const int v = i >> 10, k = i & 1023; const float c = (v < 8) ? F.in[I_C][v * 1024 + k] : F.in[I_CCTX][k]; sv[i] = c / (1.0f + __expf(-c)); }
                have = true; __syncthreads();
            }
            const int layer = u / 96, cb = (u % 96) * 64, col = F.tid & 63, kg = F.tid >> 6;
            const float* W = F.in[I_WADA] + (size_t)layer * D * 6144 + cb + col;
            float acc[9];
#pragma unroll
            for (int v = 0; v < 9; ++v) acc[v] = 0.f;
#pragma unroll 1
            for (int k0 = kg * 128; k0 < kg * 128 + 128; k0 += 32) { float w[32];
#pragma unroll
                for (int i = 0; i < 32; ++i) w[i] = W[(size_t)(k0 + i) * 6144];
#pragma unroll
                for (int i = 0; i < 32; ++i)
#pragma unroll
                    for (int v = 0; v < 9; ++v) acc[v] += sv[v * 1024 + k0 + i] * w[i]; }
#pragma unroll
            for (int v = 0; v < 9; ++v) red[(kg * 9 + v) * 64 + col] = acc[v];
            __syncthreads();
            for (int i = F.tid; i < 9 * 64; i += NTHREADS) { const int v = i >> 6, c = i & 63; float s = 0.f;
#pragma unroll
                for (int g = 0; g < 8; ++g) s += red[(g * 9 + v) * 64 + c];
                const int gc = cb + c; s += F.in[I_BADA][layer * 6144 + gc];
                ((float*)(F.ws + WS_MOD))[((size_t)(layer * 9 + v) * 6 + (gc >> 10)) * 1024 + (gc & 1023)] = s; }
            __syncthreads();
        }
        __syncthreads();
    }
#ifdef FP8_SELFTEST
    if (F.bid == 0 && F.wave == 0) { const bool ok = fp8_selftest(F.lane); if (!ok && F.lane == 0) ((unsigned*)(F.ws + WS_CTL))[8] = 1u; }
    __syncthreads();
#endif
    if (F.bid == F.G - 1 && F.tid < 16) {
        const int f = F.tid; const double r = 1.0 / sqrt(sqrt(10.0));
        double th = 1.0; for (int i = 0; i < f; ++i) th *= r;
        double c1 = 1.0, s1 = 0.0; { double term = 1.0; const double t2 = th * th; c1 = 0.0; s1 = 0.0; double ct = 1.0, st = th;
            for (int n = 0; n < 14; ++n) { c1 += ct; s1 += st; ct = -ct * t2 / (double)((2 * n + 1) * (2 * n + 2)); st = -st * t2 / (double)((2 * n + 2) * (2 * n + 3)); } (void)term; }
        double c = 1.0, s = 0.0; float* rc = (float*)(F.ws + WS_ROPE); float* rs = rc + 1024;
        for (int p = 0; p < 64; ++p) { rc[p * 16 + f] = (float)c; rs[p * 16 + f] = (float)s; const double cn = c * c1 - s * s1, sn = s * c1 + c * s1; c = cn; s = sn; }
    }
    {
        LAS float* scr = (LAS float*)(F.lds + F.wave * 17408);
        const int gw = F.bid * NWAVES + F.wave, NGW = F.G * NWAVES;
        constexpr int I_G8 = 16 * 48, I_O8 = 16 * 16, I_IN1 = 16 * 40, I_A = 4 * 16, I_B = 8 * 16, I_C2 = 4 * 16, I_O = 16 * 16, I_EI = NEXP * 16 * 16, I_EO = NEXP * 8 * 16;
        constexpr int PER_LAYER = I_G8 + I_O8 + I_IN1 + I_A + I_B + I_C2 + I_O + I_EI + I_EO;
        for (int it = gw; it < ((mode == 3) ? 0 : 2 * PER_LAYER); it += NGW) {
            const int layer = it / PER_LAYER; int r = it % PER_LAYER;
            unsigned char* wl = F.ws + WS_W + (size_t)layer * W_LAYER;
            if (r < I_G8) { const int kb = r / 48, nb = r % 48; p0_transpose_item8(F.in[I_WIN] + (size_t)layer * D * IN_COLS, IN_COLS, D, 2576 + 64 * nb, 64 * kb, (unsigned char*)(wl + W_G8), 64 * nb, scr, F.lane); continue; } r -= I_G8;
            if (r < I_O8) { const int kb = r / 16, nb = r % 16; p0_transpose_item8(F.in[I_WOUT] + (size_t)layer * D * D, D, D, 64 * nb, 64 * kb, (unsigned char*)(wl + W_O8), 64 * nb, scr, F.lane); continue; } r -= I_O8;
            if (r < I_IN1) { const int kb = r / 40, nb = r % 40; p0_transpose_item(F.in[I_WIN] + (size_t)layer * D * IN_COLS, IN_COLS, D, 64 * nb, 64 * kb, (bf16*)(wl + W_IN), 64 * nb, scr, F.lane); continue; } r -= I_IN1;
            if (r < I_A) { const int kb = r / 16, nb = r % 16; p0_transpose_item(F.in[I_WPA] + (size_t)layer * 256 * D, D, 256, 64 * nb, 64 * kb, (bf16*)(wl + W_PA), 64 * nb, scr, F.lane); continue; } r -= I_A;
            if (r < I_B) { const int kb = r / 16, nb = r % 16;
                p0_transpose_item(F.in[I_WPB] + (size_t)layer * 512 * D + (size_t)(kb >> 2) * 256 * D, D, 256, 64 * nb, 64 * (kb & 3), (bf16*)(wl + W_PB) + (size_t)(kb >> 2) * D * 256, 64 * nb, scr, F.lane); continue; } r -= I_B;
            if (r < I_C2) { const int kb = r / 16, nb = r % 16; p0_transpose_item(F.in[I_WPC] + (size_t)layer * 256 * D, D, 256, 64 * nb, 64 * kb, (bf16*)(wl + W_PC), 64 * nb, scr, F.lane); continue; } r -= I_C2;
            if (r < I_O) { const int kb = r / 16, nb = r % 16; p0_transpose_item(F.in[I_WOUT] + (size_t)layer * D * D, D, D, 64 * nb, 64 * kb, (bf16*)(wl + W_O), 64 * nb, scr, F.lane); continue; } r -= I_O;
            if (r < I_EI) { const int e = r / 256, q = r % 256, kb = q / 16, nb = q % 16, n0 = 64 * nb;
                const int s = n0 >> 9, pn = (n0 & 511) >> 7, i0 = n0 & 127;
                p0_transpose_item8(F.in[I_WEI] + ((size_t)layer * NEXP + e) * D * D, D, D, n0, 64 * kb, (unsigned char*)(wl + W_EI) + (size_t)e * D * D, 256 * pn + 128 * s + i0, scr, F.lane, mode); continue; } r -= I_EI;
            { const int e = r / 128, q = r % 128, kb = q / 16, nb = q % 16;
                p0_transpose_item8(F.in[I_WEO] + ((size_t)layer * NEXP + e) * DEXP * D, D, DEXP, 64 * nb, 64 * kb, (unsigned char*)(wl + W_EO) + (size_t)e * D * DEXP, 64 * nb, scr, F.lane, mode); }
        }
        for (int i = F.bid * NTHREADS + F.tid; i < 2 * 48 * 1024; i += F.G * NTHREADS) {
            const int layer = i / (48 * 1024), q = i % (48 * 1024), n = q >> 10, k = q & 1023;
            float w = 0.f; if (n < 4) w = F.in[I_WRG][((size_t)layer * D + k) * 4 + n]; else if (n < 36) w = F.in[I_WRE][((size_t)layer * D + k) * 32 + (n - 4)];
            const unsigned hi = pk2(w, 0.f) & 0xffffu; const float lo = w - __uint_as_float(hi << 16);
            bf16* wr = (bf16*)(F.ws + WS_WR) + (size_t)layer * 2 * 48 * 1024;
            wr[n * 1024 + k] = (bf16)hi; wr[48 * 1024 + n * 1024 + k] = (bf16)(pk2(lo, 0.f) & 0xffffu);
        }
        for (int i = F.bid * NTHREADS + F.tid; i < 2 * 256 * 128; i += F.G * NTHREADS) {
            const int layer = i / (256 * 128), q = i % (256 * 128), n = q >> 7, k0 = (q & 127) * 8;
            v4u o = {0u, 0u, 0u, 0u};
            if (n < 16) { const float* w = F.in[I_WIN] + (size_t)layer * D * IN_COLS + 2560 + n;
                o.x = pk2(w[(size_t)(k0 + 0) * IN_COLS], w[(size_t)(k0 + 1) * IN_COLS]); o.y = pk2(w[(size_t)(k0 + 2) * IN_COLS], w[(size_t)(k0 + 3) * IN_COLS]);
                o.z = pk2(w[(size_t)(k0 + 4) * IN_COLS], w[(size_t)(k0 + 5) * IN_COLS]); o.w = pk2(w[(size_t)(k0 + 6) * IN_COLS], w[(size_t)(k0 + 7) * IN_COLS]); }
            *(v4u*)((bf16*)(F.ws + WS_W + (size_t)layer * W_LAYER + W_IN) + (size_t)(5632 + n) * D + k0) = o;
        }
    }
}

__device__ __forceinline__ void row_load(const float* p, int lane, f32x4 (&v)[4]) {
#pragma unroll
    for (int j = 0; j < 4; ++j) v[j] = ((const f32x4*)p)[lane + 64 * j];
}
__device__ __forceinline__ void row_stats(const f32x4 (&v)[4], float& mean, float& rstd) {
    float s = 0.f;
#pragma unroll
    for (int j = 0; j < 4; ++j) s += (v[j].x + v[j].y) + (v[j].z + v[j].w);
    mean = wave_sum(s) * (1.f / D); float q = 0.f;
#pragma unroll
    for (int j = 0; j < 4; ++j) { const f32x4 d = v[j] - mean; q += (d.x * d.x + d.y * d.y) + (d.z * d.z + d.w * d.w); }
    rstd = 1.0f / sqrtf(wave_sum(q) * (1.f / D) + LN_EPS);
}
__device__ __forceinline__ void row_store_bf16(bf16* p, int lane, const f32x4 (&v)[4]) {
#pragma unroll
    for (int j = 0; j < 4; ++j) { v2u o; o.x = pk2(v[j].x, v[j].y); o.y = pk2(v[j].z, v[j].w); ((v2u*)p)[lane + 64 * j] = o; }
}
__device__ __forceinline__ void row_store_fp8(unsigned char* p, int lane, const f32x4 (&v)[4]) {
#pragma unroll
    for (int j = 0; j < 4; ++j) { int q8 = 0; q8 = __builtin_amdgcn_cvt_pk_fp8_f32(v[j].x, v[j].y, q8, false); q8 = __builtin_amdgcn_cvt_pk_fp8_f32(v[j].z, v[j].w, q8, true); ((unsigned*)p)[lane + 64 * j] = (unsigned)q8; }
}
__device__ __forceinline__ const float* mod_ptr(const Frame& F, int layer, int vec, int part) { return (const float*)(F.ws + WS_MOD) + ((size_t)(layer * 9 + vec) * 6 + part) * 1024; }
__device__ __forceinline__ int row_vec(int row) { return row < NLAT ? (row >> 12) : 8; }
__device__ __forceinline__ void row_modulate(f32x4 (&v)[4], const float* shift, const float* scale, int lane) {
    float mean, rstd; row_stats(v, mean, rstd);
#pragma unroll
    for (int j = 0; j < 4; ++j) { const f32x4 sh = ((const f32x4*)shift)[lane + 64 * j], sc = ((const f32x4*)scale)[lane + 64 * j]; v[j] = (v[j] - mean) * rstd * (sc + 1.0f) + sh; }
}
typedef float f32x4m __attribute__((ext_vector_type(4)));
__device__ __forceinline__ void xa_store(unsigned char* ws, int row, int lane, int j, const f32x4 v) {
    const unsigned b0 = __float_as_uint(v.x) + 0x80u, b1 = __float_as_uint(v.y) + 0x80u, b2 = __float_as_uint(v.z) + 0x80u, b3 = __float_as_uint(v.w) + 0x80u;
    v2u h; h.x = (b0 >> 16) | (b1 & 0xffff0000u); h.y = (b2 >> 16) | (b3 & 0xffff0000u);
    const unsigned l = ((b0 >> 8) & 0xffu) | (b1 & 0xff00u) | ((b2 << 8) & 0xff0000u) | ((b3 << 16) & 0xff000000u);
    ((v2u*)(ws + WS_XA + (size_t)row * (D * 2)))[lane + 64 * j] = h; ((unsigned*)(ws + WS_XAL + (size_t)row * D))[lane + 64 * j] = l;
}
__device__ __forceinline__ f32x4 xa_load_raw(const unsigned char* ws, int row, int lane, int j) {
    const v2u h = ((const v2u*)(ws + WS_XA + (size_t)row * (D * 2)))[lane + 64 * j]; const unsigned l = ((const unsigned*)(ws + WS_XAL + (size_t)row * D))[lane + 64 * j];
    return (f32x4){__uint_as_float(h.x), __uint_as_float(h.y), __uint_as_float(l), 0.f};
}
__device__ __forceinline__ f32x4 xa_decode(const f32x4 r) {
    const unsigned hx = __float_as_uint(r.x), hy = __float_as_uint(r.y), l = __float_as_uint(r.z);
    return (f32x4){__uint_as_float((hx << 16) | ((l & 0xffu) << 8)), __uint_as_float((hx & 0xffff0000u) | (l & 0xff00u)), __uint_as_float((hy << 16) | ((l >> 8) & 0xff00u)), __uint_as_float((hy & 0xffff0000u) | ((l >> 16) & 0xff00u))};
}
__device__ __forceinline__ void gate_rows_mfma(Frame& F, int layer_w, int wg, int rpw) {
    VM_WAIT(); __syncthreads();
    const bf16* H = (const bf16*)(F.ws + WS_H); const bf16* Wg = (const bf16*)(F.ws + WS_W + (size_t)layer_w * W_LAYER + W_IN) + (size_t)ZW * D;
    float* GT = (float*)(F.ws + WS_GATES);
    LAS f32x4m* P = (LAS f32x4m*)(F.lds);
    constexpr int NT = 9; const int l15 = F.lane & 15, lq = F.lane >> 4;
    const bf16* bh = Wg + (size_t)l15 * D + 8 * lq + 128 * F.wave;
    bf16x8 bfr[4], afr[NT][4];
#pragma unroll
    for (int i = 0; i < 4; ++i) bfr[i] = *(const bf16x8*)(bh + 32 * i);
#pragma unroll
    for (int t = 0; t < NT; ++t) { int arow = 16 * t + l15; if (arow >= rpw) arow = rpw - 1;
        const bf16* ah = H + (size_t)(wg * rpw + arow) * D + 8 * lq + 128 * F.wave;
#pragma unroll
        for (int i = 0; i < 4; ++i) afr[t][i] = *(const bf16x8*)(ah + 32 * i); }
#pragma unroll
    for (int t = 0; t < NT; ++t) { f32x4m acc = (f32x4m){0.f, 0.f, 0.f, 0.f};
#pragma unroll
        for (int i = 0; i < 4; ++i) acc = __builtin_amdgcn_mfma_f32_16x16x32_bf16(afr[t][i], bfr[i], acc, 0, 0, 0);
        P[(t * NWAVES + F.wave) * 64 + F.lane] = acc; }
    __syncthreads();
    for (int i = F.tid; i < NT * 64; i += NTHREADS) { const int t = i >> 6, ln = i & 63; f32x4m s = P[(t * NWAVES) * 64 + ln];
#pragma unroll
        for (int w = 1; w < NWAVES; ++w) s += P[(t * NWAVES + w) * 64 + ln];
#pragma unroll
        for (int q = 0; q < 4; ++q) { const int r = 16 * t + 4 * (ln >> 4) + q; if (r < rpw) GT[(size_t)(wg * rpw + r) * 16 + (ln & 15)] = s[q]; } }
    __syncthreads();
}
__device__ __forceinline__ int seg_split(int row_first, int rpw) {
    if (row_first < NLAT) { const int bnd = ((row_first >> 12) + 1) << 12; if (bnd < row_first + rpw) return bnd - row_first; }
    return rpw;
}
__device__ __forceinline__ int seg_first(int rlo, int wave) { return rlo + ((((wave - rlo) % NWAVES) + NWAVES) % NWAVES); }
__device__ __forceinline__ void ln0_phase(Frame& F) {
    const int rpw = MTOT / 256;
    for (int wg = F.bid; wg < 256; wg += F.G) {
        const int row_first = wg * rpw, rsplit = seg_split(row_first, rpw);
        for (int seg = 0; seg < 2; ++seg) {
            const int rlo = seg ? rsplit : 0, rhi = seg ? rpw : rsplit; if (rlo >= rhi) continue;
            const int vec = row_vec(row_first + rlo); const float* sh = mod_ptr(F, 0, vec, 0); const float* sc = mod_ptr(F, 0, vec, 1);
            f32x4 vsh[4], vsc[4];
#pragma unroll
            for (int j = 0; j < 4; ++j) { vsh[j] = ((const f32x4*)sh)[F.lane + 64 * j]; vsc[j] = ((const f32x4*)sc)[F.lane + 64 * j] + 1.0f; }
            int r = seg_first(rlo, F.wave);
            f32x4 nx[4];
            if (r < rhi) { const int row = row_first + r; row_load(row < NLAT ? F.in[I_X] + (size_t)row * D : F.in[I_CTX] + (size_t)(row - NLAT) * D, F.lane, nx); }
            for (; r < rhi; r += NWAVES) {
                const int row = row_first + r; f32x4 v[4];
#pragma unroll
                for (int j = 0; j < 4; ++j) v[j] = nx[j];
                if (r + NWAVES < rhi) { const int row2 = row + NWAVES; row_load(row2 < NLAT ? F.in[I_X] + (size_t)row2 * D : F.in[I_CTX] + (size_t)(row2 - NLAT) * D, F.lane, nx); }
                float mean, rstd; row_stats(v, mean, rstd);
#pragma unroll
                for (int j = 0; j < 4; ++j) v[j] = (v[j] - mean) * rstd * vsc[j] + vsh[j];
                row_store_bf16((bf16*)(F.ws + WS_H) + (size_t)row * D, F.lane, v); row_store_fp8((unsigned char*)(F.ws + WS_H8) + (size_t)row * D, F.lane, v);
            }
        }
        gate_rows_mfma(F, 0, wg, rpw);
    }
}
__device__ __forceinline__ void ln1_phase(Frame& F, int layer, int M) {
    const int rpw = M / 256;
    LAS int* hist = (LAS int*)(F.lds + LDS_HIST); LAS int* base = (LAS int*)(F.lds + LDS_BASE); LAS int* pairs = (LAS int*)(F.lds + LDS_PAIRS);
    LAS float* bias = (LAS float*)(F.lds + LDS_BIAS);
    if (F.tid < 4) bias[F.tid] = F.in[I_BRG][layer * 4 + F.tid]; else if (F.tid < 36) bias[F.tid] = F.in[I_BRE][layer * 32 + F.tid - 4];
    const float* g1 = F.in[I_LN1G] + layer * D; const float* b1 = F.in[I_LN1B] + layer * D;
    const bf16* WRh = (const bf16*)(F.ws + WS_WR) + (size_t)layer * 2 * 48 * 1024; const bf16* WRl = WRh + 48 * 1024;
    bf16* HLO = (bf16*)(F.ws + WS_HLO);
    for (int wg = F.bid; wg < 256; wg += F.G) {
        if (F.tid < 32) hist[F.tid] = 0;
        {
        const int row_first = wg * rpw, rsplit = seg_split(row_first, rpw);
        f32x4 vg1[4], vb1[4];
#pragma unroll
        for (int j = 0; j < 4; ++j) { vg1[j] = ((const f32x4*)g1)[F.lane + 64 * j]; vb1[j] = ((const f32x4*)b1)[F.lane + 64 * j]; }
        for (int seg = 0; seg < 2; ++seg) {
            const int rlo = seg ? rsplit : 0, rhi = seg ? rpw : rsplit; if (rlo >= rhi) continue;
            const int vec = row_vec(row_first + rlo); const float* gate = mod_ptr(F, layer, vec, 2); const float* sh = mod_ptr(F, layer, vec, 3); const float* sc = mod_ptr(F, layer, vec, 4);
            f32x4 vgate[4], vsh[4], vsc[4];
#pragma unroll
            for (int j = 0; j < 4; ++j) { vgate[j] = ((const f32x4*)gate)[F.lane + 64 * j]; vsh[j] = ((const f32x4*)sh)[F.lane + 64 * j]; vsc[j] = ((const f32x4*)sc)[F.lane + 64 * j] + 1.0f; }
#define LN1_XP(rw) ((rw) < NLAT ? F.in[I_X] + (size_t)(rw) * D : F.in[I_CTX] + (size_t)((rw) - NLAT) * D)
#define LN1_LOAD(BX, BY, rw) do { if (layer == 0) row_load(LN1_XP(rw), F.lane, BX); else { _Pragma("unroll") for (int j = 0; j < 4; ++j) BX[j] = xa_load_raw(F.ws, (rw), F.lane, j); } const bf16* yl_ = (const bf16*)(F.ws + WS_YL) + (size_t)(rw) * D; \
                _Pragma("unroll") for (int j = 0; j < 4; ++j) BY[j] = ((const v2u*)yl_)[F.lane + 64 * j]; } while (0)
#define LN1_STEP(BX, BY, rr) do { const int row = row_first + (rr); f32x4 v[4]; v2u y[4]; \
                _Pragma("unroll") for (int j = 0; j < 4; ++j) { v[j] = (layer == 0) ? BX[j] : xa_decode(BX[j]); y[j] = BY[j]; } \
                if ((rr) + 2 * NWAVES < rhi) LN1_LOAD(BX, BY, row + 2 * NWAVES); \
                _Pragma("unroll") for (int j = 0; j < 4; ++j) { const f32x4 g = vgate[j]; \
                    v[j].x = DN_ALPHA * v[j].x + g.x * bflo(y[j].x); v[j].y = DN_ALPHA * v[j].y + g.y * bfhi(y[j].x); v[j].z = DN_ALPHA * v[j].z + g.z * bflo(y[j].y); v[j].w = DN_ALPHA * v[j].w + g.w * bfhi(y[j].y); } \
                float mean, rstd; row_stats(v, mean, rstd); \
                _Pragma("unroll") for (int j = 0; j < 4; ++j) { v[j] = (v[j] - mean) * rstd * vg1[j] + vb1[j]; \
                    xa_store(F.ws, row, F.lane, j, v[j]); } \
                row_stats(v, mean, rstd); \
                _Pragma("unroll") for (int j = 0; j < 4; ++j) { v[j] = (v[j] - mean) * rstd * vsc[j] + vsh[j]; \
                    int q8 = 0; q8 = __builtin_amdgcn_cvt_pk_fp8_f32(v[j].x, v[j].y, q8, false); q8 = __builtin_amdgcn_cvt_pk_fp8_f32(v[j].z, v[j].w, q8, true); \
                    ((unsigned*)((unsigned char*)(F.ws + WS_H8) + (size_t)row * D))[F.lane + 64 * j] = (unsigned)q8; \
                    typedef float f32x2q_ __attribute__((ext_vector_type(2))); const f32x2q_ d01 = __builtin_amdgcn_cvt_pk_f32_fp8(q8, false), d23 = __builtin_amdgcn_cvt_pk_f32_fp8(q8, true); \
                    v2u lo; lo.x = pk2(v[j].x - d01.x, v[j].y - d01.y); lo.y = pk2(v[j].z - d23.x, v[j].w - d23.y);     \
                    ((v2u*)(HLO + (size_t)row * D))[F.lane + 64 * j] = lo; } } while (0)
            int r = seg_first(rlo, F.wave);
            f32x4 ax[4], bx[4]; v2u ay[4], by[4];
            if (r < rhi) LN1_LOAD(ax, ay, row_first + r);
            if (r + NWAVES < rhi) LN1_LOAD(bx, by, row_first + r + NWAVES);
            for (; r < rhi; r += 2 * NWAVES) {
                LN1_STEP(ax, ay, r);
                if (r + NWAVES < rhi) LN1_STEP(bx, by, r + NWAVES);
            }
#undef LN1_STEP
#undef LN1_LOAD
#undef LN1_XP
        }
        }
        VM_WAIT(); __syncthreads();
        {
        constexpr int NT = 9;
        const int l15 = F.lane & 15, lq = F.lane >> 4;
        LAS f32x4m* P = (LAS f32x4m*)(F.lds);
        LAS float* LG = (LAS float*)(F.lds + 2 * NWAVES * 64 * 3 * 16);
        const bf16* bh = WRh + (size_t)l15 * D + 8 * lq + 128 * F.wave; const bf16* bl = WRl + (size_t)l15 * D + 8 * lq + 128 * F.wave;
        asm volatile("" : "+v"(bh), "+v"(bl));
        bf16x8 bhi[3][4], blo[3][4];
#pragma unroll
        for (int c = 0; c < 3; ++c)
#pragma unroll
            for (int i = 0; i < 4; ++i) { bhi[c][i] = *(const bf16x8*)(bh + (size_t)c * 16 * D + 32 * i); blo[c][i] = *(const bf16x8*)(bl + (size_t)c * 16 * D + 32 * i); }
#pragma unroll 1
        for (int g = 0; g < (NT + 1) / 2; ++g) {
            v2u a8[2][4]; bf16x8 alo[2][4];
#pragma unroll
            for (int tt = 0; tt < 2; ++tt) { int arow = 16 * (2 * g + tt) + l15; if (arow >= rpw) arow = rpw - 1;
                const unsigned char* ah = (const unsigned char*)(F.ws + WS_H8) + (size_t)(wg * rpw + arow) * D + 8 * lq + 128 * F.wave; const bf16* al = HLO + (size_t)(wg * rpw + arow) * D + 8 * lq + 128 * F.wave;
#pragma unroll
                for (int i = 0; i < 4; ++i) { a8[tt][i] = *(const v2u*)(ah + 32 * i); alo[tt][i] = *(const bf16x8*)(al + 32 * i); } }
#pragma unroll
            for (int tt = 0; tt < 2; ++tt) {
                f32x4m acc[3];
#pragma unroll
                for (int c = 0; c < 3; ++c) acc[c] = (f32x4m){0.f, 0.f, 0.f, 0.f};
#pragma unroll
                for (int i = 0; i < 4; ++i) {
                    typedef float f32x2q_ __attribute__((ext_vector_type(2)));
                    const f32x2q_ e01 = __builtin_amdgcn_cvt_pk_f32_fp8((int)a8[tt][i].x, false), e23 = __builtin_amdgcn_cvt_pk_f32_fp8((int)a8[tt][i].x, true), e45 = __builtin_amdgcn_cvt_pk_f32_fp8((int)a8[tt][i].y, false), e67 = __builtin_amdgcn_cvt_pk_f32_fp8((int)a8[tt][i].y, true);
                    v4u ah4; ah4.x = pk2(e01.x, e01.y); ah4.y = pk2(e23.x, e23.y); ah4.z = pk2(e45.x, e45.y); ah4.w = pk2(e67.x, e67.y);
                    const bf16x8 a_hi = __builtin_bit_cast(bf16x8, ah4);
#pragma unroll
                    for (int c = 0; c < 3; ++c) {
                        acc[c] = __builtin_amdgcn_mfma_f32_16x16x32_bf16(alo[tt][i], bhi[c][i], acc[c], 0, 0, 0);
                        acc[c] = __builtin_amdgcn_mfma_f32_16x16x32_bf16(a_hi, blo[c][i], acc[c], 0, 0, 0);
                        acc[c] = __builtin_amdgcn_mfma_f32_16x16x32_bf16(a_hi, bhi[c][i], acc[c], 0, 0, 0); }
                }
#pragma unroll
                for (int c = 0; c < 3; ++c) P[((tt * NWAVES + F.wave) * 64 + F.lane) * 3 + c] = acc[c];
            }
            __syncthreads();
            for (int i = F.tid; i < 2 * 3 * 64; i += NTHREADS) { const int tt = i / 192, c = (i % 192) >> 6, ln = i & 63; f32x4m sacc = P[((tt * NWAVES) * 64 + ln) * 3 + c];
#pragma unroll
                for (int w = 1; w < NWAVES; ++w) sacc += P[((tt * NWAVES + w) * 64 + ln) * 3 + c];
#pragma unroll
                for (int q = 0; q < 4; ++q) LG[(16 * (2 * g + tt) + 4 * (ln >> 4) + q) * 48 + 16 * c + (ln & 15)] = sacc[q]; }
            __syncthreads();
        }
        if (F.tid < rpw) {
                const int row = wg * rpw + F.tid; const LAS float* lg = LG + F.tid * 48;
                float gl[4];
#pragma unroll
                for (int i = 0; i < 4; ++i) gl[i] = lg[i] + bias[i];
                int gs = 0; float gm = gl[0];
#pragma unroll
                for (int i = 1; i < 4; ++i) if (gl[i] > gm) { gm = gl[i]; gs = i; }
                float gden = 0.f;
#pragma unroll
                for (int i = 0; i < 4; ++i) gden += __expf(gl[i] - gm);
                const float gprob = 1.0f / gden;
                float el[8];
#pragma unroll
                for (int i = 0; i < 8; ++i) el[i] = lg[4 + 8 * gs + i] + bias[4 + 8 * gs + i];
                int i1 = 0; float l1 = el[0];
#pragma unroll
                for (int i = 1; i < 8; ++i) if (el[i] > l1) { l1 = el[i]; i1 = i; }
                int i2 = -1; float l2 = -3.0e38f;
#pragma unroll
                for (int i = 0; i < 8; ++i) if (i != i1 && el[i] > l2) { l2 = el[i]; i2 = i; }
                const float ex = __expf(l2 - l1), p1 = 1.0f / (1.0f + ex), p2 = ex * p1;
                float* wt = (float*)(F.ws + WS_WTS) + (size_t)row * 2; wt[0] = p1 * gprob; wt[1] = p2 * gprob;
                const int e1 = gs * 8 + i1, e2 = gs * 8 + i2;
                const int k1 = atomicAdd((int*)&hist[e1], 1), k2 = atomicAdd((int*)&hist[e2], 1);
                pairs[F.tid * 2] = e1 | (k1 << 8); pairs[F.tid * 2 + 1] = e2 | (k2 << 8);
        }
        }
        __syncthreads();
        if (F.tid < 32) base[F.tid] = __hip_atomic_fetch_add((int*)(F.ws + WS_CTL) + CW_CNTG + layer * 32 + F.tid, hist[F.tid], RLX_AGENT);
        __syncthreads();
        if (F.tid < 2 * rpw) { const int pr = pairs[F.tid], e = pr & 255, p = base[e] + (pr >> 8), row = wg * rpw + (F.tid >> 1);
            ((int*)(F.ws + WS_SLOT))[(size_t)row * 2 + (F.tid & 1)] = (e << 20) | p; ((int*)(F.ws + WS_TOKE))[(size_t)e * MTOT + p] = row; }
        __syncthreads();
    }
}
__device__ __forceinline__ void ln2_phase(Frame& F, int layer, int M) {
    const int rpw = M / 256; const bool last = (layer == DEPTH - 1);
    const float* g2 = F.in[I_LN2G] + layer * D; const float* b2 = F.in[I_LN2B] + layer * D;
    LAS int* tot = (LAS int*)(F.lds + LDS_TOT); LAS int* base = (LAS int*)(F.lds + LDS_BASE);
    if (F.tid < 32) tot[F.tid] = __hip_atomic_load((int*)(F.ws + WS_CTL) + CW_CNTG + layer * 32 + F.tid, RLX_AGENT);
    __syncthreads();
    if (F.tid < 32) { int ps = 0; for (int e = 0; e < F.tid; ++e) ps += ((tot[e] + 255) >> 8) << 8; base[F.tid] = ps; }
    __syncthreads();
#define LN2_SLOT(q) (base[(q) >> 20] + ((q) & 0xFFFFF))
    const int* SL = (const int*)(F.ws + WS_SLOT); const float* WT = (const float*)(F.ws + WS_WTS); const unsigned char* Y = (const unsigned char*)(F.ws + WS_XG);
    for (int wg = F.bid; wg < 256; wg += F.G) {
        const int row_first = wg * rpw, rsplit = seg_split(row_first, rpw);
        f32x4 vg2[4], vb2[4];
#pragma unroll
        for (int j = 0; j < 4; ++j) { vg2[j] = ((const f32x4*)g2)[F.lane + 64 * j]; vb2[j] = ((const f32x4*)b2)[F.lane + 64 * j]; }
        for (int seg = 0; seg < 2; ++seg) {
            const int rlo = seg ? rsplit : 0, rhi = seg ? rpw : rsplit; if (rlo >= rhi) continue;
            const int vec = row_vec(row_first + rlo); const float* gate = mod_ptr(F, layer, vec, 5);
            f32x4 vgate[4], vsh[4], vsc[4];
#pragma unroll
            for (int j = 0; j < 4; ++j) { vgate[j] = ((const f32x4*)gate)[F.lane + 64 * j]; vsh[j] = vgate[j]; vsc[j] = vgate[j]; }
            if (!last) { const float* sh = mod_ptr(F, layer + 1, vec, 0); const float* sc = mod_ptr(F, layer + 1, vec, 1);
#pragma unroll
                for (int j = 0; j < 4; ++j) { vsh[j] = ((const f32x4*)sh)[F.lane + 64 * j]; vsc[j] = ((const f32x4*)sc)[F.lane + 64 * j] + 1.0f; } }
            int r = seg_first(rlo, F.wave);
            f32x4 nx[4]; unsigned na[4], nb[4]; float nw0 = 0.f, nw1 = 0.f; int s0n = 0, s1n = 0;
            if (r < rhi) { const int row = row_first + r;
#pragma unroll
                for (int j = 0; j < 4; ++j) nx[j] = xa_load_raw(F.ws, row, F.lane, j);
                const int q0 = SL[(size_t)row * 2], q1 = SL[(size_t)row * 2 + 1]; const int s0 = LN2_SLOT(q0), s1 = LN2_SLOT(q1); nw0 = WT[(size_t)row * 2]; nw1 = WT[(size_t)row * 2 + 1];
#pragma unroll
                for (int j = 0; j < 4; ++j) { na[j] = ((const unsigned*)(Y + (size_t)s0 * D))[F.lane + 64 * j]; nb[j] = ((const unsigned*)(Y + (size_t)s1 * D))[F.lane + 64 * j]; }
                if (r + NWAVES < rhi) { s0n = SL[(size_t)(row + NWAVES) * 2]; s1n = SL[(size_t)(row + NWAVES) * 2 + 1]; } }
            for (; r < rhi; r += NWAVES) {
                const int row = row_first + r;
                f32x4 v[4]; unsigned a[4], b[4]; const float w0 = nw0 * (1.0f / 16.0f), w1 = nw1 * (1.0f / 16.0f);
#pragma unroll
                for (int j = 0; j < 4; ++j) { v[j] = xa_decode(nx[j]); a[j] = na[j]; b[j] = nb[j]; }
                if (r + NWAVES < rhi) { const int row2 = row + NWAVES;
#pragma unroll
                    for (int j = 0; j < 4; ++j) nx[j] = xa_load_raw(F.ws, row2, F.lane, j);
                    nw0 = WT[(size_t)row2 * 2]; nw1 = WT[(size_t)row2 * 2 + 1];
#pragma unroll
                    for (int j = 0; j < 4; ++j) { na[j] = ((const unsigned*)(Y + (size_t)LN2_SLOT(s0n) * D))[F.lane + 64 * j]; nb[j] = ((const unsigned*)(Y + (size_t)LN2_SLOT(s1n) * D))[F.lane + 64 * j]; }
                    if (r + 2 * NWAVES < rhi) { s0n = SL[(size_t)(row2 + NWAVES) * 2]; s1n = SL[(size_t)(row2 + NWAVES) * 2 + 1]; } }
#pragma unroll
                for (int j = 0; j < 4; ++j) { const f32x4 g = vgate[j];
                    typedef float f32x2q __attribute__((ext_vector_type(2)));
                    const f32x2q a01 = __builtin_amdgcn_cvt_pk_f32_fp8((int)a[j], false), a23 = __builtin_amdgcn_cvt_pk_f32_fp8((int)a[j], true), b01 = __builtin_amdgcn_cvt_pk_f32_fp8((int)b[j], false), b23 = __builtin_amdgcn_cvt_pk_f32_fp8((int)b[j], true);
                    v[j].x = DN_ALPHA * v[j].x + g.x * (w0 * a01.x + w1 * b01.x); v[j].y = DN_ALPHA * v[j].y + g.y * (w0 * a01.y + w1 * b01.y);
                    v[j].z = DN_ALPHA * v[j].z + g.z * (w0 * a23.x + w1 * b23.x); v[j].w = DN_ALPHA * v[j].w + g.w * (w0 * a23.y + w1 * b23.y); }
                float mean, rstd; row_stats(v, mean, rstd);
#ifdef FP8_SELFTEST
                if (last && ((const unsigned*)(F.ws + WS_CTL))[8] != 0u) { mean = __builtin_nanf(""); }
#endif
#pragma unroll
                for (int j = 0; j < 4; ++j) { v[j] = (v[j] - mean) * rstd * vg2[j] + vb2[j]; if (last) ((f32x4*)(F.out + (size_t)row * D))[F.lane + 64 * j] = v[j]; else xa_store(F.ws, row, F.lane, j, v[j]); }
                if (!last) { row_stats(v, mean, rstd);
#pragma unroll
                    for (int j = 0; j < 4; ++j) v[j] = (v[j] - mean) * rstd * vsc[j] + vsh[j];
                    row_store_bf16((bf16*)(F.ws + WS_H) + (size_t)row * D, F.lane, v); row_store_fp8((unsigned char*)(F.ws + WS_H8) + (size_t)row * D, F.lane, v); }
            }
        }
        if (!last) gate_rows_mfma(F, layer + 1, wg, rpw);
    }
}
#undef LN2_SLOT

__device__ __forceinline__ void unpack8(const v4u w, float (&f)[8]) { f[0] = bflo(w.x); f[1] = bfhi(w.x); f[2] = bflo(w.y); f[3] = bfhi(w.y); f[4] = bflo(w.z); f[5] = bfhi(w.z); f[6] = bflo(w.w); f[7] = bfhi(w.w); }
__device__ __forceinline__ void conv_phase(Frame& F, int layer, int M) {
    const bf16* Z = (const bf16*)(F.ws + WS_Z); bf16* YA = (bf16*)(F.ws + WS_YA);
    const float* cw = F.in[I_CONVW] + layer * 3 * 256;
    const int total = M * 32;
    for (int i = F.bid * NTHREADS + F.tid; i < total; i += F.G * NTHREADS) {
        const int row = i >> 5, c0 = (i & 31) * 8;
        int t, len; if (row < NLAT) { t = row & (SEQ - 1); len = SEQ; } else { t = (row - NLAT) & (CTXL - 1); len = CTXL; }
        const bf16* zr = Z + (size_t)row * ZC;
        float z0[8], a[8], b[8], acc[8];
        unpack8(*(const v4u*)(zr + Z_AB + c0), z0);
        unpack8(*(const v4u*)(zr + Z_AC + c0), a); unpack8(*(const v4u*)(zr + Z_AX + c0), b);
#pragma unroll
        for (int j = 0; j < 8; ++j) acc[j] = cw[256 + c0 + j] * (a[j] * b[j]);
        if (t > 0) { unpack8(*(const v4u*)(zr - ZC + Z_AC + c0), a); unpack8(*(const v4u*)(zr - ZC + Z_AX + c0), b);
#pragma unroll
            for (int j = 0; j < 8; ++j) acc[j] += cw[c0 + j] * (a[j] * b[j]); }
        if (t < len - 1) { unpack8(*(const v4u*)(zr + ZC + Z_AC + c0), a); unpack8(*(const v4u*)(zr + ZC + Z_AX + c0), b);
#pragma unroll
            for (int j = 0; j < 8; ++j) acc[j] += cw[512 + c0 + j] * (a[j] * b[j]); }
        v4u o; o.x = pk2(z0[0] * acc[0], z0[1] * acc[1]); o.y = pk2(z0[2] * acc[2], z0[3] * acc[3]); o.z = pk2(z0[4] * acc[4], z0[5] * acc[5]); o.w = pk2(z0[6] * acc[6], z0[7] * acc[7]);
        *(v4u*)(YA + (size_t)row * 256 + c0) = o;
    }
}

constexpr int KPITCH = 72;
constexpr int VPITCH = 96;
__device__ __forceinline__ void rope8(const v4u own, const v4u par, const float* cs, const float* sn, bool second, v4u& out) {
    float a[8], b[8]; unpack8(own, a); unpack8(par, b); float o[8];
#pragma unroll
    for (int j = 0; j < 8; ++j) o[j] = second ? (a[j] * cs[j] + b[j] * sn[j]) : (a[j] * cs[j] - b[j] * sn[j]);
    out.x = pk2(o[0], o[1]); out.y = pk2(o[2], o[3]); out.z = pk2(o[4], o[5]); out.w = pk2(o[6], o[7]);
}
__device__ __forceinline__ void rope8s(const v4u own, const v4u par, const float* cs, const float* sn, bool second, float scale, v4u& out) {
    float a[8], b[8]; unpack8(own, a); unpack8(par, b); float o[8];
#pragma unroll
    for (int j = 0; j < 8; ++j) o[j] = (second ? (a[j] * cs[j] + b[j] * sn[j]) : (a[j] * cs[j] - b[j] * sn[j])) * scale;
    out.x = pk2(o[0], o[1]); out.y = pk2(o[2], o[3]); out.z = pk2(o[4], o[5]); out.w = pk2(o[6], o[7]);
}
__device__ __forceinline__ void attn_stage_write(LAS bf16* Ks, LAS bf16* Vt, const v4u g_own, const v4u g_par, const v4u g_v, bool win, int kt, int sr, int sc, int sd0, const float* RC, const float* RS) {
    v4u own = g_own;
    if (win) { const int pos = (sc < 4) ? kt : sr, f0 = sd0 & 15; v4u o; rope8(g_own, g_par, RC + pos * 16 + f0, RS + pos * 16 + f0, (sd0 & 16) != 0, o); own = o; }
    *(LAS v4u*)(Ks + sr * KPITCH + sd0) = own;
    *(LAS v4u*)(Vt + sr * VPITCH + sd0) = g_v;
}
__device__ __forceinline__ void attn_unit(Frame& F, int layer, int b, int qb, int kvh, bool ctxq) {
    const bf16* Z = (const bf16*)(F.ws + WS_Z); bf16* YB = (bf16*)(F.ws + WS_YB);
    const float* RC = (const float*)(F.ws + WS_ROPE); const float* RS = RC + 1024;
    constexpr int BUFB = 64 * (KPITCH + VPITCH) * 2;
    const int lane = F.lane, w = F.wave, l31 = lane & 31, hh = lane >> 5;
    const int head = kvh * 4 + (w >> 1), tq0 = qb * 64 + (w & 1) * 32;
    const int qrow = (ctxq ? (NLAT + b * CTXL) : (b * SEQ)) + tq0 + l31, qpos = tq0 + l31;
    constexpr float C2 = 0.125f * 1.4426950408889634f;
    bf16x8 qf[4];
    {
        const bf16* qp = Z + (size_t)qrow * ZC + Z_Q + head * 64 + 8 * hh;
        v4u raw[4];
#pragma unroll
        for (int ks = 0; ks < 4; ++ks) raw[ks] = *(const v4u*)(qp + 16 * ks);
        if (!ctxq) { const int pr = qpos >> 6, pc = qpos & 63; v4u o0, o1, o2, o3;
            rope8s(raw[0], raw[1], RC + pr * 16 + 8 * hh, RS + pr * 16 + 8 * hh, false, C2, o0); rope8s(raw[1], raw[0], RC + pr * 16 + 8 * hh, RS + pr * 16 + 8 * hh, true, C2, o1);
            rope8s(raw[2], raw[3], RC + pc * 16 + 8 * hh, RS + pc * 16 + 8 * hh, false, C2, o2); rope8s(raw[3], raw[2], RC + pc * 16 + 8 * hh, RS + pc * 16 + 8 * hh, true, C2, o3);
            raw[0] = o0; raw[1] = o1; raw[2] = o2; raw[3] = o3; }
        else {
#pragma unroll
            for (int ks = 0; ks < 4; ++ks) { float f[8]; unpack8(raw[ks], f); raw[ks].x = pk2(f[0] * C2, f[1] * C2); raw[ks].y = pk2(f[2] * C2, f[3] * C2); raw[ks].z = pk2(f[4] * C2, f[5] * C2); raw[ks].w = pk2(f[6] * C2, f[7] * C2); } }
#pragma unroll
        for (int ks = 0; ks < 4; ++ks) qf[ks] = __builtin_bit_cast(bf16x8, raw[ks]);
    }
    f32x16 oacc[2];
#pragma unroll
    for (int a = 0; a < 2; ++a)
#pragma unroll
        for (int i = 0; i < 16; ++i) oacc[a][i] = 0.f;
    float mrun = F.in[I_SINK][layer * 8 + head] * 1.4426950408889634f, lrun = 1.f;
    const int wlo = ctxq ? 0 : (qb - 2 < 0 ? 0 : qb - 2), whi = ctxq ? -1 : (qb + 2 > 63 ? 63 : qb + 2);
    const int ntiles = 4 + (whi - wlo + 1);
    const int sr = F.tid >> 3, sc = F.tid & 7, sd0 = 8 * sc;
    v4u g_own, g_par, g_v;
    {   const int krow = NLAT + b * CTXL + sr; const bf16* kp = Z + (size_t)krow * ZC + Z_K + kvh * 64;
        g_own = *(const v4u*)(kp + sd0); g_par = g_own; g_v = *(const v4u*)(Z + (size_t)krow * ZC + Z_V + kvh * 64 + sd0); }
    __syncthreads();
    attn_stage_write((LAS bf16*)(F.lds), (LAS bf16*)(F.lds) + 64 * KPITCH, g_own, g_par, g_v, false, 0, sr, sc, sd0, RC, RS);
    __syncthreads();
    for (int ti = 0; ti < ntiles; ++ti) {
        const bool win = ti >= 4; const int kt = win ? wlo + (ti - 4) : ti;
        LAS bf16* Ks = (LAS bf16*)(F.lds + (ti & 1) * BUFB); LAS bf16* Vt = Ks + 64 * KPITCH;
        const LAS bf16* vtr0 = Vt + (4 * hh + ((lane & 15) >> 2)) * VPITCH + 16 * ((lane >> 4) & 1) + 4 * (lane & 3);
        const bool more = ti + 1 < ntiles; const bool nwin = ti + 1 >= 4; const int nkt = nwin ? wlo + (ti + 1 - 4) : ti + 1;
        if (more) {
            const int krow = (nwin ? (b * SEQ + 64 * nkt) : (NLAT + b * CTXL + 64 * nkt)) + sr; const bf16* kp = Z + (size_t)krow * ZC + Z_K + kvh * 64;
            g_own = *(const v4u*)(kp + sd0); g_par = *(const v4u*)(kp + (sd0 ^ 16)); g_v = *(const v4u*)(Z + (size_t)krow * ZC + Z_V + kvh * 64 + sd0);
        }
        f32x16 s0, s1;
#pragma unroll
        for (int i = 0; i < 16; ++i) { s0[i] = 0.f; s1[i] = 0.f; }
#pragma unroll
        for (int ks = 0; ks < 4; ++ks) { const bf16x8 kf0 = *(const LAS bf16x8*)(Ks + l31 * KPITCH + 16 * ks + 8 * hh), kf1 = *(const LAS bf16x8*)(Ks + (32 + l31) * KPITCH + 16 * ks + 8 * hh);
            s0 = MFMA32(kf0, qf[ks], s0); s1 = MFMA32(kf1, qf[ks], s1); }
        if (win && (kt == qb - 2 || kt == qb + 2)) {
#pragma unroll
            for (int i = 0; i < 16; ++i) { const int kpos = 64 * kt + (i & 3) + 8 * (i >> 2) + 4 * hh; const int d0 = qpos - kpos, d1 = d0 - 32;
                if (d0 > 128 || d0 < -128) s0[i] = -__builtin_inff(); if (d1 > 128 || d1 < -128) s1[i] = -__builtin_inff(); }
        }
        float mx = -3.0e38f;
#pragma unroll
        for (int i = 0; i < 16; ++i) mx = fmaxf(mx, fmaxf(s0[i], s1[i]));
        mx = fmaxf(mx, __shfl_xor(mx, 32));
        const float mnew = fmaxf(mrun, mx);
        if (__any(mnew > mrun)) { const float alpha = __builtin_amdgcn_exp2f(mrun - mnew); lrun *= alpha;
#pragma unroll
            for (int dt = 0; dt < 2; ++dt)
#pragma unroll
                for (int i = 0; i < 16; ++i) oacc[dt][i] *= alpha; }
        mrun = mnew;
        float sum = 0.f;
#pragma unroll
        for (int i = 0; i < 16; ++i) { const float p0 = __builtin_amdgcn_exp2f(s0[i] - mnew), p1 = __builtin_amdgcn_exp2f(s1[i] - mnew); s0[i] = p0; s1[i] = p1; sum += p0 + p1; }
        sum += __shfl_xor(sum, 32);
        lrun += sum;
        bf16x8 pf[2][2];
#pragma unroll
        for (int sp = 0; sp < 2; ++sp) { v4u pk;
            pk.x = pk2(s0[8 * sp + 0], s0[8 * sp + 1]); pk.y = pk2(s0[8 * sp + 2], s0[8 * sp + 3]); pk.z = pk2(s0[8 * sp + 4], s0[8 * sp + 5]); pk.w = pk2(s0[8 * sp + 6], s0[8 * sp + 7]); pf[0][sp] = __builtin_bit_cast(bf16x8, pk);
            pk.x = pk2(s1[8 * sp + 0], s1[8 * sp + 1]); pk.y = pk2(s1[8 * sp + 2], s1[8 * sp + 3]); pk.z = pk2(s1[8 * sp + 4], s1[8 * sp + 5]); pk.w = pk2(s1[8 * sp + 6], s1[8 * sp + 7]); pf[1][sp] = __builtin_bit_cast(bf16x8, pk); }
#pragma unroll
        for (int dt = 0; dt < 2; ++dt)
#pragma unroll
            for (int kt2 = 0; kt2 < 2; ++kt2)
#pragma unroll
                for (int sp = 0; sp < 2; ++sp) { const LAS bf16* vp = vtr0 + (32 * kt2 + 16 * sp) * VPITCH + 32 * dt;
                    oacc[dt] = MFMA32(tr_frag(vp, vp + 8 * VPITCH), pf[kt2][sp], oacc[dt]); }
        if (more) { LAS bf16* Kn = (LAS bf16*)(F.lds + ((ti + 1) & 1) * BUFB); attn_stage_write(Kn, Kn + 64 * KPITCH, g_own, g_par, g_v, nwin, nkt, sr, sc, sd0, RC, RS); }
        __syncthreads();
    }
    { const float inv = 1.0f / lrun; bf16* op = YB + (size_t)(head >> 2) * MTOT * 256 + (size_t)qrow * 256 + (head & 3) * 64 + 4 * hh;
#pragma unroll
        for (int dt = 0; dt < 2; ++dt)
#pragma unroll
            for (int g = 0; g < 4; ++g) { v2u o; o.x = pk2(oacc[dt][4 * g] * inv, oacc[dt][4 * g + 1] * inv); o.y = pk2(oacc[dt][4 * g + 2] * inv, oacc[dt][4 * g + 3] * inv);
                *(v2u*)(op + 32 * dt + 8 * g) = o; } }
}
__device__ __forceinline__ void attn_phase(Frame& F, int layer) {
    const int nlat = NBATCH * 64 * 2, nall = nlat + (layer == 0 ? NBATCH * 4 * 2 : 0);
    for (int u = F.bid; u < nall; u += F.G) {
        if (u < nlat) { const int kvh = u & 1, qb = (u >> 1) & 63, b = u >> 7; attn_unit(F, layer, b, qb, kvh, false); }
        else { const int v = u - nlat, kvh = v & 1, qb = (v >> 1) & 3, b = v >> 3; attn_unit(F, layer, b, qb, kvh, true); }
    }
    __syncthreads();
}

__device__ __forceinline__ int mlstm_row0(int b, int dir, int j) {
    if (j < 4) { const int cb = dir ? 3 - j : j; return NLAT + b * CTXL + 64 * cb; }
    const int lb = dir ? 67 - j : j - 4; return b * SEQ + 64 * lb;
}
__device__ __forceinline__ float log_sigmoid(float x) { return fminf(x, 0.f) - log1pf(__expf(-fabsf(x))); }
__device__ __forceinline__ float scan_sum(float v, int lane, int dir) {
#pragma unroll
    for (int o = 1; o < 64; o <<= 1) { const float t = dir ? __shfl_down(v, o) : __shfl_up(v, o); const bool ok = dir ? (lane + o < 64) : (lane >= o); v += ok ? t : 0.f; }
    return v;
}
__device__ __forceinline__ float scan_max(float v, int lane, int dir) {
#pragma unroll
    for (int o = 1; o < 64; o <<= 1) { const float t = dir ? __shfl_down(v, o) : __shfl_up(v, o); const bool ok = dir ? (lane + o < 64) : (lane >= o); v = ok ? fmaxf(v, t) : v; }
    return v;
}
constexpr int TP = 72;
__device__ __forceinline__ void mlstm_c1_phase(Frame& F, int layer) {
    const bf16* Z = (const bf16*)(F.ws + WS_Z); const float* GT = (const float*)(F.ws + WS_GATES);
    float* CST = (float*)(F.ws + WS_CST); float* NST = (float*)(F.ws + WS_NST); float* MG = (float*)(F.ws + WS_MG);
    LAS bf16* KT = (LAS bf16*)(F.lds + F.wave * (2 * 64 * TP * 2)); LAS bf16* VT = KT + 64 * TP;
    const int lane = F.lane, l31 = lane & 31, hh = lane >> 5;
    const float* gb = F.in[I_GATEB] + layer * 16;
    for (int u = F.bid * NWAVES + F.wave; u < NSCAN * NCHUNK; u += F.G * NWAVES) {
        const int sc = u / NCHUNK, j = u % NCHUNK, b = sc >> 3, h = (sc >> 1) & 3, dir = sc & 1;
        const int row0 = mlstm_row0(b, dir, j);
        const float li = GT[(size_t)(row0 + lane) * 16 + 8 * dir + h] + gb[8 * dir + h];
        const float lf = log_sigmoid(GT[(size_t)(row0 + lane) * 16 + 8 * dir + 4 + h] + gb[8 * dir + 4 + h]);
        const float bc = scan_sum(lf, lane, dir), g = wave_sum(lf);
        const float wl = g - bc + li, ml = wave_max(wl), ew = __expf(wl - ml) * 0.125f;
#pragma unroll
        for (int i = 0; i < 8; ++i) { const int t = 8 * i + (lane >> 3), c = lane & 7; const float et = __shfl(ew, t);
            float kv[8]; unpack8(*(const v4u*)(Z + (size_t)(row0 + t) * ZC + Z_MK + h * 64 + 8 * c), kv);
            const v4u vv = *(const v4u*)(Z + (size_t)(row0 + t) * ZC + Z_MV + h * 64 + 8 * c);
            v4u kk; kk.x = pk2(kv[0] * et, kv[1] * et); kk.y = pk2(kv[2] * et, kv[3] * et); kk.z = pk2(kv[4] * et, kv[5] * et); kk.w = pk2(kv[6] * et, kv[7] * et);
            *(LAS v4u*)(KT + t * TP + 8 * c) = kk; *(LAS v4u*)(VT + t * TP + 8 * c) = vv; }
        LDS_WAIT();
        const int trb = (8 * hh + ((lane & 15) >> 2)) * TP + 16 * ((lane >> 4) & 1) + 4 * (lane & 3);
        {
            f32x16 cacc[2][2];
#pragma unroll
            for (int a = 0; a < 2; ++a)
#pragma unroll
                for (int c = 0; c < 2; ++c)
#pragma unroll
                    for (int i = 0; i < 16; ++i) cacc[a][c][i] = 0.f;
#pragma unroll
            for (int ks = 0; ks < 4; ++ks) {
                bf16x8 af[2], bfr[2];
#pragma unroll
                for (int x = 0; x < 2; ++x) { const LAS bf16* pv = VT + trb + 16 * ks * TP + 32 * x; const LAS bf16* pk = KT + trb + 16 * ks * TP + 32 * x;
                    af[x] = tr_frag(pv, pv + 4 * TP); bfr[x] = tr_frag(pk, pk + 4 * TP); }
#pragma unroll
                for (int et = 0; et < 2; ++et)
#pragma unroll
                    for (int dt = 0; dt < 2; ++dt) cacc[et][dt] = MFMA32(af[et], bfr[dt], cacc[et][dt]);
            }
            float* cp = CST + (size_t)u * 4096;
#pragma unroll
            for (int et = 0; et < 2; ++et)
#pragma unroll
                for (int dt = 0; dt < 2; ++dt)
#pragma unroll
                    for (int i = 0; i < 16; ++i) cp[(32 * et + (i & 3) + 8 * (i >> 2) + 4 * hh) * 64 + 32 * dt + l31] = cacc[et][dt][i];
        }
        __builtin_amdgcn_sched_barrier(0);
        {
            const bf16x8 ones = (bf16x8){0x3f80, 0x3f80, 0x3f80, 0x3f80, 0x3f80, 0x3f80, 0x3f80, 0x3f80};
            f32x16 nacc[2];
#pragma unroll
            for (int a = 0; a < 2; ++a)
#pragma unroll
                for (int i = 0; i < 16; ++i) nacc[a][i] = 0.f;
#pragma unroll
            for (int ks = 0; ks < 4; ++ks)
#pragma unroll
                for (int dt = 0; dt < 2; ++dt) { const LAS bf16* pk = KT + trb + 16 * ks * TP + 32 * dt; nacc[dt] = MFMA32(ones, tr_frag(pk, pk + 4 * TP), nacc[dt]); }
            if (hh == 0) { NST[(size_t)u * 64 + l31] = nacc[0][0]; NST[(size_t)u * 64 + 32 + l31] = nacc[1][0]; }
        }
        if (lane == 0) { MG[u] = g; MG[NSCAN * NCHUNK + u] = ml; }
        LDS_WAIT();
    }
}
__device__ __forceinline__ void mlstm_c2_phase(Frame& F) {
    float* CST = (float*)(F.ws + WS_CST); float* NST = (float*)(F.ws + WS_NST); float* MG = (float*)(F.ws + WS_MG);
    constexpr int NBT = 17;
    for (int u = F.bid; u < NSCAN * 4; u += F.G) {
        const int sc = u >> 2, qtr = u & 3; const bool nown = (qtr == 0 && F.tid < 64);
        const float* cp = CST + (size_t)sc * NCHUNK * 4096 + qtr * 1024 + F.tid; bf16* cb = (bf16*)(F.ws + WS_CSTB) + (size_t)sc * NCHUNK * 4096 + qtr * 1024 + F.tid; float* np = NST + (size_t)sc * NCHUNK * 64 + (F.tid & 63);
        float c0 = 0.f, c1 = 0.f, n0 = 0.f, mst = 0.f;
#pragma unroll 1
        for (int jb = 0; jb < NCHUNK; jb += NBT) {
            float x0[NBT], x1[NBT], xn[NBT], gj[NBT], mj[NBT];
#pragma unroll
            for (int i = 0; i < NBT; ++i) { x0[i] = cp[(size_t)(jb + i) * 4096]; x1[i] = cp[(size_t)(jb + i) * 4096 + 512]; xn[i] = nown ? np[(jb + i) * 64] : 0.f;
                gj[i] = MG[sc * NCHUNK + jb + i]; mj[i] = MG[NSCAN * NCHUNK + sc * NCHUNK + jb + i]; }
#pragma unroll
            for (int i = 0; i < NBT; ++i) {
                const float mnew = fmaxf(gj[i] + mst, mj[i]), a = __expf(gj[i] + mst - mnew), bb = __expf(mj[i] - mnew);
                { const unsigned pk = pk2(c0, c1); cb[(size_t)(jb + i) * 4096] = (bf16)(pk & 0xffffu); cb[(size_t)(jb + i) * 4096 + 512] = (bf16)(pk >> 16); } c0 = a * c0 + bb * x0[i]; c1 = a * c1 + bb * x1[i];
                if (nown) { np[(jb + i) * 64] = n0; n0 = a * n0 + bb * xn[i]; }
                if (qtr == 0 && F.tid == 0) MG[2 * NSCAN * NCHUNK + sc * NCHUNK + jb + i] = mst;
                mst = mnew;
            }
        }
    }
}
__device__ __forceinline__ void mlstm_c3_phase(Frame& F, int layer) {
    const bf16* Z = (const bf16*)(F.ws + WS_Z); const float* GT = (const float*)(F.ws + WS_GATES);
    const float* CST = (const float*)(F.ws + WS_CST); const float* NST = (const float*)(F.ws + WS_NST); const float* MG = (const float*)(F.ws + WS_MG);
    bf16* YC = (bf16*)(F.ws + WS_YC);
    constexpr int VP3 = 96;
    LAS bf16* VT = (LAS bf16*)(F.lds + F.wave * 16384); LAS float* US = (LAS float*)(F.lds + F.wave * 16384 + 64 * VP3 * 2);
    const int lane = F.lane, l31 = lane & 31, hh = lane >> 5;
    const float* gb = F.in[I_GATEB] + layer * 16; const float* nw = F.in[I_NORMW] + layer * 256;
    const int nlat = NBATCH * 4 * 64, nun = nlat + ((layer == 0) ? 2 * NBATCH * 4 * 4 : 0);
    const int nwv = F.G * NWAVES, npass1 = (nlat + nwv - 1) / nwv, npass2 = (nun - nlat + nwv - 1) / nwv;
    for (int it = 0; it < npass1 + npass2; ++it) {
        const int u = (it < npass1) ? it * nwv + F.bid * NWAVES + F.wave : nlat + (it - npass1) * nwv + F.wave * F.G + F.bid;
        if (u >= ((it < npass1) ? nlat : nun)) continue;
        int tb, bh, st_lo = 0, st_hi = 2;
        if (u < nlat) { tb = 4 + (u & 63); bh = u >> 6; } else { const int v = u - nlat; st_lo = v & 1; st_hi = st_lo + 1; tb = (v >> 1) & 3; bh = v >> 3; }
        const int b = bh >> 2, h = bh & 3;
        const int row0 = tb < 4 ? NLAT + b * CTXL + 64 * tb : b * SEQ + 64 * (tb - 4);
        float mm[2], einter[2], floorv[2]; int cidx[2];
#pragma unroll
        for (int dir = 0; dir < 2; ++dir) {
            const int j = dir ? (tb < 4 ? 3 - tb : 71 - tb) : tb, sc = (b * 4 + h) * 2 + dir; cidx[dir] = sc * NCHUNK + j;
            const float li = GT[(size_t)(row0 + lane) * 16 + 8 * dir + h] + gb[8 * dir + h];
            const float lf = log_sigmoid(GT[(size_t)(row0 + lane) * 16 + 8 * dir + 4 + h] + gb[8 * dir + 4 + h]);
            const float bc = scan_sum(lf, lane, dir), uu = li - bc, pm = scan_max(uu, lane, dir), mprev = MG[2 * NSCAN * NCHUNK + cidx[dir]];
            mm[dir] = fmaxf(mprev, pm); einter[dir] = __expf(mprev - mm[dir]); floorv[dir] = __expf(-bc - mm[dir]);
            US[dir * 64 + lane] = uu;
        }
#pragma unroll
        for (int i = 0; i < 8; ++i) { const int t = 8 * i + (lane >> 3), c = lane & 7;
            *(LAS v4u*)(VT + t * VP3 + 8 * c) = *(const v4u*)(Z + (size_t)(row0 + t) * ZC + Z_MV + h * 64 + 8 * c); }
        LDS_WAIT();
        const LAS bf16* vtr0 = VT + (4 * hh + ((lane & 15) >> 2)) * VP3 + 16 * ((lane >> 4) & 1) + 4 * (lane & 3);
#pragma unroll 1
        for (int st = st_lo; st < st_hi; ++st) {
            const int s = 32 * st + l31;
            bf16x8 qf[4];
#pragma unroll
            for (int ks = 0; ks < 4; ++ks) qf[ks] = *(const bf16x8*)(Z + (size_t)(row0 + s) * ZC + Z_MQ + h * 64 + 16 * ks + 8 * hh);
            f32x16 hm[2];
#pragma unroll
            for (int et = 0; et < 2; ++et)
#pragma unroll
                for (int i = 0; i < 16; ++i) hm[et][i] = 0.f;
#pragma unroll 1
            for (int dir = 0; dir < 2; ++dir) {
                const float mms = __shfl(dir ? mm[1] : mm[0], s), eis = __shfl(dir ? einter[1] : einter[0], s), fls = __shfl(dir ? floorv[1] : floorv[0], s);
                const int ci = dir ? cidx[1] : cidx[0]; const int sm4 = s - 4 * hh;
                f32x16 na[2]; float dsum = 0.f;
#pragma unroll
                for (int et = 0; et < 2; ++et)
#pragma unroll
                    for (int i = 0; i < 16; ++i) na[et][i] = 0.f;
#pragma unroll
                for (int rt = 0; rt < 2; ++rt) {
                    f32x16 sT;
#pragma unroll
                    for (int i = 0; i < 16; ++i) sT[i] = 0.f;
#pragma unroll
                    for (int ks = 0; ks < 4; ++ks) { const bf16x8 kf = *(const bf16x8*)(Z + (size_t)(row0 + 32 * rt + l31) * ZC + Z_MK + h * 64 + 16 * ks + 8 * hh); sT = MFMA32(kf, qf[ks], sT); }
#pragma unroll
                    for (int g = 0; g < 4; ++g) { const f32x4 u4 = *(const LAS f32x4*)(US + dir * 64 + 32 * rt + 8 * g + 4 * hh);
#pragma unroll
                        for (int x = 0; x < 4; ++x) { const int rc = 32 * rt + 8 * g + x; const bool ok = dir ? (rc >= sm4) : (rc <= sm4);
                            const float wv = ok ? __expf(u4[x] - mms) : 0.f; const float v = sT[4 * g + x] * 0.125f * wv; sT[4 * g + x] = v; dsum += v; } }
#pragma unroll
                    for (int sp = 0; sp < 2; ++sp) { v4u pk; pk.x = pk2(sT[8 * sp], sT[8 * sp + 1]); pk.y = pk2(sT[8 * sp + 2], sT[8 * sp + 3]); pk.z = pk2(sT[8 * sp + 4], sT[8 * sp + 5]); pk.w = pk2(sT[8 * sp + 6], sT[8 * sp + 7]);
                        const bf16x8 pf = __builtin_bit_cast(bf16x8, pk);
#pragma unroll
                        for (int et = 0; et < 2; ++et) { const LAS bf16* vp = vtr0 + (32 * rt + 16 * sp) * VP3 + 32 * et;
                            na[et] = MFMA32(tr_frag(vp, vp + 8 * VP3), pf, na[et]); } }
                }
                dsum += __shfl_xor(dsum, 32);
                float qn = 0.f; const float* np = NST + (size_t)ci * 64;
#pragma unroll
                for (int ks = 0; ks < 4; ++ks) { float qv[8]; unpack8(__builtin_bit_cast(v4u, qf[ks]), qv); const f32x4 n0 = *(const f32x4*)(np + 16 * ks + 8 * hh), n1 = *(const f32x4*)(np + 16 * ks + 8 * hh + 4);
                    qn += qv[0] * n0.x + qv[1] * n0.y + qv[2] * n0.z + qv[3] * n0.w + qv[4] * n1.x + qv[5] * n1.y + qv[6] * n1.z + qv[7] * n1.w; }
                qn += __shfl_xor(qn, 32);
                const float den = dsum + eis * qn, inv = 1.0f / fmaxf(fabsf(den), fls);
                const bf16* cp = (const bf16*)(F.ws + WS_CSTB) + (size_t)ci * 4096;
#pragma unroll
                for (int et = 0; et < 2; ++et) {
                    f32x16 nb;
#pragma unroll
                    for (int i = 0; i < 16; ++i) nb[i] = 0.f;
#pragma unroll
                    for (int ks = 0; ks < 4; ++ks) nb = MFMA32(*(const bf16x8*)(cp + (32 * et + l31) * 64 + 16 * ks + 8 * hh), qf[ks], nb);
#pragma unroll
                    for (int i = 0; i < 16; ++i) hm[et][i] += (na[et][i] + eis * nb[i]) * inv;
                }
            }
            float sum = 0.f;
#pragma unroll
            for (int et = 0; et < 2; ++et)
#pragma unroll
                for (int i = 0; i < 16; ++i) sum += hm[et][i];
            sum += __shfl_xor(sum, 32); const float mu = sum * (1.f / 64.f); float q = 0.f;
#pragma unroll
            for (int et = 0; et < 2; ++et)
#pragma unroll
                for (int i = 0; i < 16; ++i) { const float d = hm[et][i] - mu; q += d * d; }
            q += __shfl_xor(q, 32); const float rstd = 1.0f / sqrtf(q * (1.f / 64.f) + LN_EPS);
            const bf16* og = Z + (size_t)(row0 + s) * ZC + Z_MO + h * 64; bf16* yp = YC + (size_t)(row0 + s) * 256 + h * 64;
#pragma unroll
            for (int et = 0; et < 2; ++et)
#pragma unroll
                for (int g = 0; g < 4; ++g) { const int e0 = 32 * et + 8 * g + 4 * hh; const v2u ov = *(const v2u*)(og + e0); const f32x4 wv = *(const f32x4*)(nw + h * 64 + e0);
                    const float y0 = (hm[et][4 * g] - mu) * rstd * wv.x * fsig(bflo(ov.x)), y1 = (hm[et][4 * g + 1] - mu) * rstd * wv.y * fsig(bfhi(ov.x));
                    const float y2 = (hm[et][4 * g + 2] - mu) * rstd * wv.z * fsig(bflo(ov.y)), y3 = (hm[et][4 * g + 3] - mu) * rstd * wv.w * fsig(bfhi(ov.y));
                    v2u o; o.x = pk2(y0, y1); o.y = pk2(y2, y3); *(v2u*)(yp + e0) = o; }
        }
        LDS_WAIT();
    }
}

__device__ __forceinline__ void moe_tables(Frame& F, int layer) {
    LAS int* tot = (LAS int*)(F.lds + LDS_TOT);
    if (F.tid < 32) tot[F.tid] = __hip_atomic_load((int*)(F.ws + WS_CTL) + CW_CNTG + layer * 32 + F.tid, RLX_AGENT);
    __syncthreads();
}
__device__ __forceinline__ int moe_tile_table(Frame& F) {
    LAS int* tot = (LAS int*)(F.lds + LDS_TOT); LAS int* te = (LAS int*)(F.lds + LDS_TILE_E); LAS int* first = (LAS int*)(F.lds + LDS_BELOW);
    int nt = 0;
    for (int e = 0; e < NEXP; ++e) { const int n = (tot[e] + 255) >> 8; for (int i = F.tid; i < n; i += NTHREADS) te[nt + i] = e; if (F.tid == 0) first[e] = nt; nt += n; }
    __syncthreads();
    return nt;
}

#define XB_TMO      128
#define XB_XCNT(j)  (256  + 64 * (j))
#define XB_XSUB(j)  (1280 + 64 * (j))
#define XB_XGEN(j)  (2304 + 64 * (j))
#define XB_TOP      3328
#define XB_TOPGEN   3392
#define XCD_BAR_WORDS 3456
#define XB_SPIN_CAP (1u << 18)

__device__ __forceinline__ unsigned xb_ld(unsigned* p)              { return __hip_atomic_load(p, __ATOMIC_RELAXED, __HIP_MEMORY_SCOPE_AGENT); }
__device__ __forceinline__ unsigned xb_add(unsigned* p, unsigned v) { return __hip_atomic_fetch_add(p, v, __ATOMIC_RELAXED, __HIP_MEMORY_SCOPE_AGENT); }
__device__ __forceinline__ unsigned xb_xcc_id() { return (unsigned)__builtin_amdgcn_s_getreg((3 << 11) | 20) & 0xFu; }
#define XB_SPIN(cond, bar) do { unsigned _sp = 0; while (cond) { __builtin_amdgcn_s_sleep(1); \
    if ((++_sp & 255u) == 0u) { if (xb_ld(&(bar)[XB_TMO])) break; if (_sp > XB_SPIN_CAP) { atomicAdd(&(bar)[XB_TMO], 1u); break; } } } } while (0)

struct XcdBarrier {
    unsigned* bar; unsigned x;
    volatile LAS unsigned* st;
};

__device__ __forceinline__ XcdBarrier xcd_barrier_post(unsigned* bar, volatile LAS unsigned* st) {
    XcdBarrier b; b.bar = bar; b.x = xb_xcc_id(); b.st = st;
    if (threadIdx.x == 0) (void)xb_add(&bar[XB_XCNT(b.x)], 1u);
    return b;
}
__device__ __forceinline__ void xcd_barrier_complete(unsigned* bar, unsigned x, unsigned& nloc, unsigned& nx) {
    const unsigned G = gridDim.x * gridDim.y * gridDim.z;
    unsigned sum, cnt, mine, sp = 0u;
    for (;;) {
        sum = 0u; cnt = 0u; mine = 0u;
#pragma unroll
        for (unsigned j = 0; j < 16; ++j) { const unsigned c = xb_ld(&bar[XB_XCNT(j)]); sum += c; cnt += (c > 0u) ? 1u : 0u; mine = (j == x) ? c : mine; }
        if (sum == G) break;
        __builtin_amdgcn_s_sleep(1);
        if ((++sp & 255u) == 0u) { if (xb_ld(&bar[XB_TMO])) break; if (sp > XB_SPIN_CAP) { atomicAdd(&bar[XB_TMO], 1u); break; } }
    }
    nloc = mine > 0u ? mine : 1u; nx = cnt > 0u ? cnt : 1u;
}

__device__ __forceinline__ void xcd_barrier(const XcdBarrier& b) {
    asm volatile("s_waitcnt vmcnt(0)" ::: "memory");
    __syncthreads();
    if (threadIdx.x == 0) {
        unsigned* bar = b.bar;
        __builtin_amdgcn_s_waitcnt(0);
        unsigned nloc = b.st[0], nx = b.st[1];
        if (nloc == 0u) { xcd_barrier_complete(bar, b.x, nloc, nx); b.st[0] = nloc; b.st[1] = nx; }
        const unsigned old = xb_add(&bar[XB_XSUB(b.x)], 1u);
        const unsigned gen = old / nloc;
        if (old + 1u == (gen + 1u) * nloc) {
            __builtin_amdgcn_fence(__ATOMIC_RELEASE, "agent");
            asm volatile("s_waitcnt vmcnt(0)" ::: "memory");
            const unsigned og = xb_add(&bar[XB_TOP], 1u);
            const unsigned tg = og / nx;
            if (og + 1u == (tg + 1u) * nx) xb_add(&bar[XB_TOPGEN], 1u);
            else XB_SPIN(xb_ld(&bar[XB_TOPGEN]) == tg, bar);
            __builtin_amdgcn_fence(__ATOMIC_ACQUIRE, "agent");
            xb_add(&bar[XB_XGEN(b.x)], 1u);
            asm volatile("s_waitcnt vmcnt(0)" ::: "memory");
        } else {
            XB_SPIN(xb_ld(&bar[XB_XGEN(b.x)]) == gen, bar);
            __builtin_amdgcn_fence(__ATOMIC_ACQUIRE, "agent");
            asm volatile("s_waitcnt vmcnt(0)" ::: "memory");
        }
    }
    __syncthreads();
}

#ifndef PHASE_SEL
#define PHASE_SEL 0xFFFF
#endif
#define PH(n) (((PHASE_SEL) >> (n)) & 1)
constexpr int N_PHASES = 2 + 11 * DEPTH;
#ifndef REPEAT_SEL
#define REPEAT_SEL 0
#endif
struct Args { const float* in[25]; float* out; unsigned char* ws; int ph_lo, ph_hi, rep, pad; };
#if MK_ONE_LAUNCH
#define GRID_BAR() xcd_barrier(bar)
#else
#define GRID_BAR() do { } while (0)
#endif
#define FENCE_PHASE() do { int z_, l_; asm volatile("s_mov_b32 %0, 0" : "=s"(z_)); asm volatile("v_mbcnt_lo_u32_b32 %0, -1, 0\n\tv_mbcnt_hi_u32_b32 %0, -1, %0" : "=v"(l_)); \
        z_ = __builtin_amdgcn_readfirstlane(z_); F.ws = args.ws + z_; F.wave = wave0 + z_; F.lane = l_; F.tid = F.wave * 64 + l_; F.lds = lds + z_; } while (0)
#define IN(k) (lo <= (k) && (k) < hi)
#ifndef REPEAT_N
#define REPEAT_N 1
#endif
#if ((REPEAT_SEL) >> 0) & 1
#define REP0 _Pragma("unroll") for (int rep_ = 0; rep_ < 1 + REPEAT_N; ++rep_)
#else
#define REP0
#endif
#if ((REPEAT_SEL) >> 1) & 1
#define REP1 _Pragma("unroll") for (int rep_ = 0; rep_ < 1 + REPEAT_N; ++rep_)
#else
#define REP1
#endif
#if ((REPEAT_SEL) >> 2) & 1
#define REP2 _Pragma("unroll") for (int rep_ = 0; rep_ < 1 + REPEAT_N; ++rep_)
#else
#define REP2
#endif
#if ((REPEAT_SEL) >> 3) & 1
#define REP3 _Pragma("unroll") for (int rep_ = 0; rep_ < 1 + REPEAT_N; ++rep_)
#else
#define REP3
#endif
#if ((REPEAT_SEL) >> 4) & 1
#define REP4 _Pragma("unroll") for (int rep_ = 0; rep_ < 1 + REPEAT_N; ++rep_)
#else
#define REP4
#endif
#if ((REPEAT_SEL) >> 5) & 1
#define REP5 _Pragma("unroll") for (int rep_ = 0; rep_ < 1 + REPEAT_N; ++rep_)
#else
#define REP5
#endif
#if ((REPEAT_SEL) >> 6) & 1
#define REP6 _Pragma("unroll") for (int rep_ = 0; rep_ < 1 + REPEAT_N; ++rep_)
#else
#define REP6
#endif
#if ((REPEAT_SEL) >> 7) & 1
#define REP7 _Pragma("unroll") for (int rep_ = 0; rep_ < 1 + REPEAT_N; ++rep_)
#else
#define REP7
#endif
#if ((REPEAT_SEL) >> 8) & 1
#define REP8 _Pragma("unroll") for (int rep_ = 0; rep_ < 1 + (layer == 0 ? REPEAT_N : 0); ++rep_)
#else
#define REP8
#endif
#if ((REPEAT_SEL) >> 9) & 1
#define REP9 _Pragma("unroll") for (int rep_ = 0; rep_ < 1 + REPEAT_N; ++rep_)
#else
#define REP9
#endif
#if ((REPEAT_SEL) >> 10) & 1
#define REP10 _Pragma("unroll") for (int rep_ = 0; rep_ < 1 + REPEAT_N; ++rep_)
#else
#define REP10
#endif
#if ((REPEAT_SEL) >> 11) & 1
#define REP11 _Pragma("unroll") for (int rep_ = 0; rep_ < 1 + REPEAT_N; ++rep_)
#else
#define REP11
#endif
#if ((REPEAT_SEL) >> 12) & 1
#define REP12 _Pragma("unroll") for (int rep_ = 0; rep_ < 1 + REPEAT_N; ++rep_)
#else
#define REP12
#endif
#define SEAM(k) do { if (IN(k) && IN((k) + 1)) GRID_BAR(); } while (0)
template <int layer> __device__ __forceinline__ void run_layer(Frame& F, const Args& args, LAS unsigned char* lds, const XcdBarrier& bar, const int lo, const int hi, const int wave0) {
        const int pb = 2 + 11 * layer;
        const int Ml = (layer == 0) ? MTOT : NLAT;
        REP2 { if (PH(2) && IN(pb + 0)) { FENCE_PHASE();
#if defined(PROBE_NULLEPI) && (((REPEAT_SEL) >> 2) & 1)
            if (rep_ > 0) {
            { pg8::Gemm g{(const bf16*)(F.ws + WS_H), (const bf16*)(F.ws + WS_W + (size_t)layer * W_LAYER + W_IN), MTOT, ZC, D};
              pg8::InprojOrder S; S.base.init(Ml, ZC, F.G, F.bid); S.nextra = (Ml == MTOT) ? 0 : 3 * (NCTX / 256); S.pm0 = NLAT / 256;
              pg8::EpiBf16<0> E{(bf16*)(F.ws + WS_Z), ZC, nullptr, 0, 0, 1.f}; pg8::EpiNull E0;
              if (PROBE_NULLEPI & 16) { g.KT = 32; S.base.init(Ml / 2, ZC, F.G, F.bid); S.nextra = 0; }
              if (PROBE_NULLEPI & 32) { g.KT = 8; S.base.init(Ml * 2 > MTOT ? MTOT : Ml * 2, ZC, F.G, F.bid); S.nextra = 0; }
              if (PROBE_NULLEPI & 1) pg8::gemm_phase<pg8::EpiNull, pg8::InprojOrder, true, true>(F.lds, g, S, E0, F.tid); else if (!(PROBE_NULLEPI & 4)) pg8::gemm_phase<pg8::EpiBf16<0>, pg8::InprojOrder, true, true>(F.lds, g, S, E, F.tid); }
            { pg8::Gemm g{(const bf16*)(F.ws + WS_H8), (const bf16*)(F.ws + WS_W + (size_t)layer * W_LAYER + W_G8), MTOT, NGC, D / 2};
              pg8::StaticOrder S; S.init(Ml, NGC, F.G, F.G - 1 - F.bid);
              pg8::EpiG8 E{(unsigned char*)(F.ws + WS_GU8), NGC, WQ_INV}; pg8::EpiNull E0;
              if (PROBE_NULLEPI & 2) pg8::gemm_phase<pg8::EpiNull, pg8::StaticOrder, true, true, true>(F.lds, g, S, E0, F.tid); else if (!(PROBE_NULLEPI & 8)) pg8::gemm_phase<pg8::EpiG8, pg8::StaticOrder, true, true, true>(F.lds, g, S, E, F.tid); }
            } else
#endif
            {
            { pg8::Gemm g{(const bf16*)(F.ws + WS_H), (const bf16*)(F.ws + WS_W + (size_t)layer * W_LAYER + W_IN), MTOT, ZC, D};
              pg8::InprojOrder S; S.base.init(Ml, ZC, F.G, F.bid); S.nextra = (Ml == MTOT) ? 0 : 3 * (NCTX / 256); S.pm0 = NLAT / 256;
              pg8::EpiBf16<0> E{(bf16*)(F.ws + WS_Z), ZC, nullptr, 0, 0, 1.f};
              pg8::gemm_phase<pg8::EpiBf16<0>, pg8::InprojOrder, true, true>(F.lds, g, S, E, F.tid); }
            { pg8::Gemm g{(const bf16*)(F.ws + WS_H8), (const bf16*)(F.ws + WS_W + (size_t)layer * W_LAYER + W_G8), MTOT, NGC, D / 2};
              pg8::StaticOrder S; S.init(Ml, NGC, F.G, F.G - 1 - F.bid);
              pg8::EpiG8 E{(unsigned char*)(F.ws + WS_GU8), NGC, WQ_INV};
              pg8::gemm_phase<pg8::EpiG8, pg8::StaticOrder, true, true, true>(F.lds, g, S, E, F.tid); }
            }
        } SEAM(pb + 0); }
        REP3 { if (PH(3) && IN(pb + 1)) { FENCE_PHASE();
#ifndef SUB_SEL
#define SUB_SEL 7
#endif
            for (int ra = 0; ra < 1 + (((REPEAT_SEL) >> 13) & 1); ++ra) attn_phase(F, layer);
            for (int rb = 0; rb < 1 + (((REPEAT_SEL) >> 14) & 1); ++rb) { __syncthreads(); mlstm_c1_phase(F, layer); }
            conv_phase(F, layer, Ml); } SEAM(pb + 1); }
        REP4 { if (PH(4) && IN(pb + 2)) { FENCE_PHASE(); mlstm_c2_phase(F); } SEAM(pb + 2); }
        REP5 { if (PH(5) && IN(pb + 3)) { FENCE_PHASE(); mlstm_c3_phase(F, layer); } SEAM(pb + 3); }
        REP6 { if (PH(6) && IN(pb + 4)) { FENCE_PHASE();
            pg8::Gemm g{(const bf16*)(F.ws + WS_YA), (const bf16*)(F.ws + WS_W + (size_t)layer * W_LAYER + W_PA), 4 * MTOT, D, 256};
            pg8::MergeOrder S{(Ml / 256) * 4, MTOT / 256, F.G, F.bid};
            pg8::EpiMerge E{(const unsigned char*)(F.ws + WS_GU8), NGC, (bf16*)(F.ws + WS_MERGED), D, MTOT / 256, (unsigned char*)(F.ws + WS_MERGED8)};
            pg8::gemm_phase<pg8::EpiMerge, pg8::MergeOrder, true, true>(F.lds, g, S, E, F.tid);
        } SEAM(pb + 4); }
        REP7 { if (PH(7) && IN(pb + 5)) { FENCE_PHASE();
            pg8::Gemm g{(const bf16*)(F.ws + WS_MERGED8), (const bf16*)(F.ws + WS_W + (size_t)layer * W_LAYER + W_O8), Ml, D, D / 2}; pg8::StaticOrder S; S.init(Ml, D, F.G, F.bid);
            pg8::EpiBf16S E{(bf16*)(F.ws + WS_YL), D, WQ_INV};
            pg8::gemm_phase<pg8::EpiBf16S, pg8::StaticOrder, true, true, true>(F.lds, g, S, E, F.tid);
        } SEAM(pb + 5); }
        REP8 { if (PH(8) && IN(pb + 6)) { FENCE_PHASE(); __syncthreads(); ln1_phase(F, layer, Ml); } SEAM(pb + 6); }
        REP10 { if (PH(10) && IN(pb + 8)) { FENCE_PHASE();
            moe_tables(F, layer); const int nt = moe_tile_table(F);
            { LAS int* tt = (LAS int*)(F.lds + LDS_TOKTAB); const int* TOKE = (const int*)(F.ws + WS_TOKE);
              const LAS int* te = (const LAS int*)(F.lds + LDS_TILE_E); const LAS int* first = (const LAS int*)(F.lds + LDS_BELOW); const LAS int* tot = (const LAS int*)(F.lds + LDS_TOT);
              for (int i = 0; i < 6; ++i) { int t, pn; pg8::MoeOrder::unit_of(i, F.G, F.bid, t, pn); if (t >= nt) break;
                  if (F.tid < 256) { const int e = te[t], p = (t - first[e]) * 256 + F.tid; tt[i * 256 + F.tid] = (p < tot[e]) ? TOKE[(size_t)e * MTOT + p] : 0; } }
              __syncthreads(); }
            pg8::Gemm g{(const bf16*)(F.ws + WS_H8), (const bf16*)(F.ws + WS_W + (size_t)layer * W_LAYER + W_EI), PMAX, D, D / 2};
            pg8::MoeGatherOrder S; S.tile_e = (const LAS int*)(F.lds + LDS_TILE_E); S.ntiles = nt; S.G = F.G; S.c = F.bid; S.tok = (const LAS int*)(F.lds + LDS_TOKTAB);
            pg8::EpiSwiGLU8 E{(unsigned char*)(F.ws + WS_ACT), DEXP, WQ_INV};
            pg8::gemm_phase<pg8::EpiSwiGLU8, pg8::MoeGatherOrder, true, true, true>(F.lds, g, S, E, F.tid);
        } SEAM(pb + 8); }
        REP11 { if (PH(11) && IN(pb + 9)) { FENCE_PHASE();
            moe_tables(F, layer); const int nt = moe_tile_table(F);
            pg8::Gemm g{(const bf16*)(F.ws + WS_ACT), (const bf16*)(F.ws + WS_W + (size_t)layer * W_LAYER + W_EO), PMAX, D, DEXP / 2};     pg8::MoeOrder S{(const LAS int*)(F.lds + LDS_TILE_E), nt, F.G, F.bid};
            pg8::EpiF8S E{(unsigned char*)(F.ws + WS_XG), D, 16.0f * WQ_INV};
            pg8::gemm_phase<pg8::EpiF8S, pg8::MoeOrder, true, true, true>(F.lds, g, S, E, F.tid);
        } SEAM(pb + 9); }
        REP12 { if (PH(12) && IN(pb + 10)) { FENCE_PHASE(); ln2_phase(F, layer, Ml); } SEAM(pb + 10); }
    }
__global__ void __launch_bounds__(NTHREADS, 2) hybrid_fwd(Args args) {
    extern __shared__ __attribute__((aligned(16))) unsigned char lds_raw[];
    LAS unsigned char* lds = (LAS unsigned char*)lds_raw;
    Frame F;
    F.lds = lds;
    F.tid = threadIdx.x; F.lane = F.tid & 63; F.wave = __builtin_amdgcn_readfirstlane(F.tid >> 6); F.G = gridDim.x; F.bid = blockIdx.x;
    const int wave0 = F.wave;
    F.in = args.in;
    F.out = args.out; F.ws = args.ws;
    volatile LAS unsigned* MISC = (volatile LAS unsigned*)(F.lds + LDS_MISC);
    if (F.tid < 32) MISC[F.tid] = 0u;
    __syncthreads();
    XcdBarrier bar; bar.bar = nullptr; bar.x = 0; bar.st = nullptr;
#if MK_ONE_LAUNCH
    bar = xcd_barrier_post((unsigned*)(F.ws + WS_CTL) + CW_BAR, MISC + 8);
#endif
    const int lo = args.ph_lo, hi = args.ph_hi;
    #ifndef P0_MODE
#define P0_MODE 0
#endif
    { int rep0_ = 0; REP0 { if (PH(0) && IN(0)) { FENCE_PHASE(); p0_prologue(F, rep0_ ? P0_MODE : 0); } SEAM(0); ++rep0_; } }
    REP1 { if (PH(1) && IN(1)) { FENCE_PHASE(); ln0_phase(F); } SEAM(1); }
#ifdef EXTRA_BARS
    for (int eb = 0; eb < EXTRA_BARS; ++eb) GRID_BAR();
#endif
    run_layer<0>(F, args, lds, bar, lo, hi, wave0);
    run_layer<1>(F, args, lds, bar, lo, hi, wave0);
}
#undef IN
#undef SEAM


extern "C" void kernel_launch(void* const* d_in, const int* in_sizes, int n_in, void* d_out, int out_size, void* d_ws, size_t ws_size, hipStream_t stream) {
    static int grid = 0;
    if (grid == 0) {
        if (n_in != 25 || in_sizes[0] != NLAT * D || out_size != NLAT * D || ws_size < WS_END) { fprintf(stderr, "kernel_launch: unexpected shapes / workspace (n_in %d, ws %zu)\n", n_in, ws_size); grid = -1; return; }
        int dev = 0, cus = 0, per_cu = 0;
        if (hipGetDevice(&dev) != hipSuccess || hipDeviceGetAttribute(&cus, hipDeviceAttributeMultiprocessorCount, dev) != hipSuccess) { grid = -1; return; }
        if (hipFuncSetAttribute((const void*)hybrid_fwd, hipFuncAttributeMaxDynamicSharedMemorySize, LDS_BYTES) != hipSuccess) { fprintf(stderr, "kernel_launch: hipFuncSetAttribute failed\n"); grid = -1; return; }
        if (hipOccupancyMaxActiveBlocksPerMultiprocessor(&per_cu, (const void*)hybrid_fwd, NTHREADS, LDS_BYTES) != hipSuccess || per_cu < 1) { fprintf(stderr, "kernel_launch: occupancy query says %d blocks per CU\n", per_cu); }
        (void)hipGetLastError();
        grid = cus;
    }
    if (grid < 0) return;
    (void)hipMemsetAsync((char*)d_ws + WS_CTL, 0, CTL_ZERO_BYTES, stream);
    Args a{};
    for (int i = 0; i < 25; ++i) a.in[i] = (const float*)d_in[i];
    a.out = (float*)d_out; a.ws = (unsigned char*)d_ws; a.rep = REPEAT_SEL; a.pad = 0;
#if MK_ONE_LAUNCH
    a.ph_lo = 0; a.ph_hi = N_PHASES;
    hipLaunchKernelGGL(hybrid_fwd, dim3(grid), dim3(NTHREADS), LDS_BYTES, stream, a);
#else
    for (int p = 0; p < N_PHASES; ++p) { a.ph_lo = p; a.ph_hi = p + 1; hipLaunchKernelGGL(hybrid_fwd, dim3(grid), dim3(NTHREADS), LDS_BYTES, stream, a); }
#endif
}
```
